# Optimizing an MI355X kernel written in HIP

```python
import jax, jax.numpy as jnp
from jax import lax
import numpy as np


D_MODEL = 1024
BATCH = 8
SEQ = 2048
DEPTH = 2

N_ATTN_HEADS = 8
ATTN_HEAD_DIM = 64
ATTN_WIDTH = N_ATTN_HEADS * ATTN_HEAD_DIM
MOBA_BLOCK = 256
MOBA_TOPK = 3
Q_CHUNK = 16
CONV_WIDTH = 512
CONV_K = 3
N_BRANCH = 2
SPLIT_SIZES = (ATTN_WIDTH, ATTN_WIDTH, ATTN_WIDTH, CONV_WIDTH, CONV_WIDTH, CONV_WIDTH, D_MODEL, D_MODEL)
IN_COLS = sum(SPLIT_SIZES)
SPLIT_POINTS = tuple(int(s) for s in np.cumsum(SPLIT_SIZES)[:-1])
PEER_HEADS = 8
PEER_NKEYS = 128
PEER_EXPERTS = PEER_NKEYS * PEER_NKEYS
PEER_DKEY = 256
PEER_HALF = PEER_DKEY // 2
PEER_TOPK = 16
PEER_TOK_CHUNK = 128

NORM_EPS = 1e-6
MASK_VALUE = -1e30

kernel_name = "hybrid_moba_shortconv_peer_adaln"


def rmsnorm(x, g):
    xf = x.astype(jnp.float32)
    y = xf * lax.rsqrt(jnp.mean(xf * xf, axis=-1, keepdims=True) + NORM_EPS)
    return (y * g.astype(jnp.float32)).astype(x.dtype)


def alibi_slopes(n):
    return jnp.asarray(np.array([2.0 ** (-8.0 * (h + 1) / n) for h in range(n)], dtype=np.float32))


def moba_attention(q, k, v, slopes):
    B, S, H, hd = q.shape
    nb = -(-S // MOBA_BLOCK)
    pad = nb * MOBA_BLOCK - S
    ksel = min(MOBA_TOPK, nb - 1)
    scale = hd ** -0.5
    q = q.transpose(0, 2, 1, 3)
    k = jnp.pad(k.transpose(0, 2, 1, 3), ((0, 0), (0, 0), (0, pad), (0, 0)))
    v = jnp.pad(v.transpose(0, 2, 1, 3), ((0, 0), (0, 0), (0, pad), (0, 0)))
    kb = k.reshape(B, H, nb, MOBA_BLOCK, hd)
    vb = v.reshape(B, H, nb, MOBA_BLOCK, hd)
    qblk = jnp.arange(S, dtype=jnp.int32) // MOBA_BLOCK
    nc = S // Q_CHUNK

    def chunks(a):
        return jnp.moveaxis(a.reshape(B, H, nc, Q_CHUNK, *a.shape[3:]), 2, 0)

    xs = {"q": chunks(q), "start": jnp.arange(nc, dtype=jnp.int32) * Q_CHUNK}
    if ksel > 0:
        kmean = jnp.mean(kb.astype(jnp.float32), axis=3)
        gate = jnp.einsum("bhtd,bhnd->bhtn", q.astype(jnp.float32), kmean)
        past = jnp.arange(nb, dtype=jnp.int32)[None, :] < qblk[:, None]
        gate = jnp.where(past, gate, MASK_VALUE)
        _, idx = lax.top_k(gate, ksel)
        valid = idx < qblk[:, None]
        xs["idx"] = chunks(idx)
        xs["valid"] = chunks(valid)
    bi = jnp.arange(B)[:, None, None, None]
    hi = jnp.arange(H)[None, :, None, None]
    offs = jnp.arange(MOBA_BLOCK, dtype=jnp.int32)

    def body(xc):
        qc = xc["q"]
        start = xc["start"]
        pos_q = start + jnp.arange(Q_CHUNK, dtype=jnp.int32)
        own = start // MOBA_BLOCK
        k_own = lax.dynamic_index_in_dim(kb, own, axis=2, keepdims=False)
        v_own = lax.dynamic_index_in_dim(vb, own, axis=2, keepdims=False)
        d_own = pos_q[:, None] - (own * MOBA_BLOCK + offs)[None, :]
        s_own = (jnp.einsum("bhtd,bhsd->bhts", qc, k_own).astype(jnp.float32) * scale
                 - slopes[:, None, None] * d_own.astype(jnp.float32))
        s_own = jnp.where(d_own >= 0, s_own, MASK_VALUE)
        if ksel == 0:
            p = jax.nn.softmax(s_own, axis=-1).astype(v.dtype)
            return jnp.einsum("bhts,bhsd->bhtd", p, v_own)
        idxc = xc["idx"]
        validc = xc["valid"]
        k_g = kb[bi, hi, idxc]
        v_g = vb[bi, hi, idxc]
        pos_sel = idxc[..., None] * MOBA_BLOCK + offs
        d_sel = pos_q[None, None, :, None, None] - pos_sel
        s_sel = (jnp.einsum("bhtd,bhtjsd->bhtjs", qc, k_g).astype(jnp.float32) * scale
                 - slopes[None, :, None, None, None] * d_sel.astype(jnp.float32))
        s_sel = jnp.where(validc[..., None], s_sel, MASK_VALUE)
        s_all = jnp.concatenate([s_sel.reshape(B, H, Q_CHUNK, ksel * MOBA_BLOCK), s_own], axis=-1)
        p = jax.nn.softmax(s_all, axis=-1).astype(v.dtype)
        p_sel = p[..., : ksel * MOBA_BLOCK].reshape(B, H, Q_CHUNK, ksel, MOBA_BLOCK)
        p_own = p[..., ksel * MOBA_BLOCK:]
        return (jnp.einsum("bhts,bhsd->bhtd", p_own, v_own)
                + jnp.einsum("bhtjs,bhtjsd->bhtd", p_sel, v_g))

    out = lax.map(body, xs)
    return out.transpose(1, 0, 3, 2, 4).reshape(B, S, H * hd)


def gated_short_conv(b_gate, c_gate, h, w_conv):
    z = c_gate * h
    y = lax.conv_general_dilated(z, w_conv[:, None, :], window_strides=(1,),
                                 padding=[(CONV_K - 1, 0)],
                                 dimension_numbers=("NWC", "WIO", "NWC"),
                                 feature_group_count=CONV_WIDTH)
    return b_gate * y


def peer(h, w_query, sub_keys, expert_u, expert_v):
    B, S, D = h.shape
    T = B * S
    hf = h.reshape(T, D)
    q = (hf @ w_query).reshape(T, PEER_HEADS, 2, PEER_HALF)
    scores = jnp.einsum("thpd,hpnd->thpn", q, sub_keys).astype(jnp.float32)
    top_v, top_i = lax.top_k(scores, PEER_TOPK)
    cand_v = top_v[:, :, 0, :, None] + top_v[:, :, 1, None, :]
    cand_i = top_i[:, :, 0, :, None] * PEER_NKEYS + top_i[:, :, 1, None, :]
    cand_v = cand_v.reshape(T, PEER_HEADS, PEER_TOPK * PEER_TOPK)
    cand_i = cand_i.reshape(T, PEER_HEADS, PEER_TOPK * PEER_TOPK)
    best_v, best_pos = lax.top_k(cand_v, PEER_TOPK)
    expert_idx = jnp.take_along_axis(cand_i, best_pos, axis=-1)
    gates = jax.nn.softmax(best_v, axis=-1).astype(h.dtype)
    nc = T // PEER_TOK_CHUNK
    xs = {"h": hf.reshape(nc, PEER_TOK_CHUNK, D),
          "idx": expert_idx.reshape(nc, PEER_TOK_CHUNK, PEER_HEADS, PEER_TOPK),
          "g": gates.reshape(nc, PEER_TOK_CHUNK, PEER_HEADS, PEER_TOPK)}

    def body(xc):
        u = jnp.take(expert_u, xc["idx"], axis=0)
        vv = jnp.take(expert_v, xc["idx"], axis=0)
        a = jax.nn.gelu(jnp.einsum("td,thkd->thk", xc["h"], u))
        return jnp.einsum("thk,thkd->td", xc["g"] * a, vv)

    return lax.map(body, xs).reshape(B, S, D)


def setup_inputs(seed: int = 0) -> dict:
    key = jax.random.key(seed)
    ks = jax.random.split(key, 16)
    L, D = DEPTH, D_MODEL

    def nrm(k, shape, s):
        return jax.random.normal(k, shape, jnp.float32) * s

    return {
        "x": nrm(ks[0], (BATCH, SEQ, D), 1.0),
        "c": nrm(ks[1], (BATCH, D), 1.0),
        "norm1_g": 1.0 + nrm(ks[2], (L, D), 0.02),
        "norm2_g": 1.0 + nrm(ks[3], (L, D), 0.02),
        "w_ada": nrm(ks[4], (L, D, 6 * D), 0.5 * D ** -0.5),
        "b_ada": nrm(ks[5], (L, 6 * D), 0.02),
        "w_in": nrm(ks[6], (L, D, IN_COLS), D ** -0.5),
        "conv_w": nrm(ks[7], (L, CONV_K, CONV_WIDTH), CONV_K ** -0.5),
        "w_attn_proj": nrm(ks[8], (L, ATTN_WIDTH, D), ATTN_WIDTH ** -0.5),
        "w_conv_proj": nrm(ks[9], (L, CONV_WIDTH, D), CONV_WIDTH ** -0.5),
        "w_out": nrm(ks[10], (L, D, D), D ** -0.5),
        "w_query": nrm(ks[11], (L, D, PEER_HEADS * PEER_DKEY), D ** -0.5),
        "sub_keys": nrm(ks[12], (L, PEER_HEADS, 2, PEER_NKEYS, PEER_HALF), PEER_HALF ** -0.5),
        "expert_u": nrm(ks[13], (L, PEER_EXPERTS, D), D ** -0.5),
        "expert_v": nrm(ks[14], (L, PEER_EXPERTS, D), PEER_HEADS ** -0.5),
        "final_g": 1.0 + nrm(ks[15], (D,), 0.02),
    }


def reference(x, c, norm1_g, norm2_g, w_ada, b_ada, w_in, conv_w, w_attn_proj, w_conv_proj,
              w_out, w_query, sub_keys, expert_u, expert_v, final_g):
    B, S, D = x.shape
    slopes = alibi_slopes(N_ATTN_HEADS)
    for l in range(DEPTH):
        ada = (c @ w_ada[l] + b_ada[l])[:, None, :]
        sh1, sc1, g1, sh2, sc2, g2 = jnp.split(ada, 6, axis=-1)
        h = rmsnorm(x, norm1_g[l]) * (1.0 + sc1) + sh1
        proj = h @ w_in[l]
        q, k, v, b_gate, c_gate, hc, gate_a, gate_c = jnp.split(proj, SPLIT_POINTS, axis=-1)
        ya = moba_attention(q.reshape(B, S, N_ATTN_HEADS, ATTN_HEAD_DIM),
                            k.reshape(B, S, N_ATTN_HEADS, ATTN_HEAD_DIM),
                            v.reshape(B, S, N_ATTN_HEADS, ATTN_HEAD_DIM), slopes)
        yc = gated_short_conv(b_gate, c_gate, hc, conv_w[l])
        merged = (jax.nn.sigmoid(gate_a) * (ya @ w_attn_proj[l])
                  + jax.nn.sigmoid(gate_c) * (yc @ w_conv_proj[l]))
        x = x + g1 * (merged @ w_out[l])
        h = rmsnorm(x, norm2_g[l]) * (1.0 + sc2) + sh2
        x = x + g2 * peer(h, w_query[l], sub_keys[l], expert_u[l], expert_v[l])
    return rmsnorm(x, final_g)
```

```cpp
#include <hip/hip_runtime.h>
#include <cstdint>
#include <cstdio>

typedef unsigned short bf16_t;
#define LAS __attribute__((address_space(3)))
#define GAS __attribute__((address_space(1)))

constexpr int D = 1024, BATCH = 8, SEQ = 2048, M = BATCH * SEQ, DEPTH = 2;
constexpr int NH = 8, HD = 64, MOBA = 256, NBLK = SEQ / MOBA;
constexpr int INC = 5120;
constexpr int OQ = 0, OKK = 512, OV = 1024, OBG = 1536, OCG = 2048, OHC = 2560, OGA = 3072, OGC = 4096;
constexpr int PH = 8, NKEY = 128, NEXP = NKEY * NKEY, DKEY = 256, HALFK = 128, PTOP = 16;
constexpr int QPW = PH * DKEY;
constexpr float EPS = 1e-6f;
constexpr float LOG2E = 1.4426950408889634f;
constexpr float C2 = 0.125f * LOG2E;

constexpr size_t MiB = 1u << 20;
constexpr size_t WS_CTL = 0, CTL_ZERO_BYTES = 2 * MiB;
constexpr size_t WS_ADA = 1 * MiB;
constexpr size_t WS_KSUM = 2 * MiB;
constexpr size_t WS_WIN = 3 * MiB;
constexpr size_t WS_WAP = 23 * MiB;
constexpr size_t WS_WCP = 25 * MiB;
constexpr size_t WS_WOUT = 27 * MiB;
constexpr size_t WS_WQ = 31 * MiB;
constexpr size_t WS_SK = 39 * MiB;
constexpr size_t WS_H = 40 * MiB;
constexpr size_t WS_PROJ = 72 * MiB;
constexpr size_t WS_QP = 72 * MiB;
constexpr size_t WS_TV = 136 * MiB;
constexpr size_t WS_TI = 152 * MiB;
constexpr size_t WS_YA = 232 * MiB;
constexpr size_t WS_YC = 248 * MiB;
constexpr size_t WS_MRG = 264 * MiB;
constexpr size_t WS_X1 = 296 * MiB;
constexpr size_t WS_EIDX = 360 * MiB;
constexpr size_t WS_EGATE = 368 * MiB;
constexpr size_t WS_EU = 376 * MiB;
constexpr size_t WS_EV = 408 * MiB;
constexpr size_t WS_ESU = 440 * MiB;
constexpr size_t WS_ESV = 441 * MiB;
constexpr size_t WS_END = 442 * MiB;

__device__ __forceinline__ float bf2f(bf16_t v) { return __uint_as_float((unsigned)v << 16); }
__device__ __forceinline__ unsigned f2bf_u(float f) { unsigned u = __float_as_uint(f); return (u + 0x7fffu + ((u >> 16) & 1u)) >> 16; }
__device__ __forceinline__ bf16_t f2bf(float f) { return (bf16_t)f2bf_u(f); }
__device__ __forceinline__ unsigned pk2(float lo, float hi) { return f2bf_u(lo) | (f2bf_u(hi) << 16); }
__device__ __forceinline__ float bflo(unsigned w) { return __uint_as_float(w << 16); }
__device__ __forceinline__ float bfhi(unsigned w) { return __uint_as_float(w & 0xffff0000u); }
__device__ __forceinline__ float sigmoidf_(float x) { return __builtin_amdgcn_rcpf(1.0f + __expf(-x)); }
__device__ __forceinline__ float gelu_tanh(float x) { const float u = 0.7978845608028654f * (x + 0.044715f * x * x * x); const float e = __expf(2.0f * u); return x - x * __builtin_amdgcn_rcpf(e + 1.0f); }
__device__ __forceinline__ float wave_sum(float v) {
#pragma unroll
    for (int o = 1; o < 64; o <<= 1) v += __shfl_xor(v, o);
    return v;
}
__device__ __forceinline__ float wave_max(float v) {
#pragma unroll
    for (int o = 1; o < 64; o <<= 1) v = fmaxf(v, __shfl_xor(v, o));
    return v;
}
__device__ __forceinline__ int laundered_tid() { int t = threadIdx.x; asm volatile("" : "+v"(t)); return t; }
#define USE_NAIVE_AT 0
#define USE_NAIVE_TK 0
#define USE_NAIVE_PE 0
#define MEGA_ONE 1

namespace pg8 {
#define PG8_LAS __attribute__((address_space(3)))
typedef unsigned short bf16_t;
typedef short bf16x8 __attribute__((ext_vector_type(8)));
typedef float f32x4 __attribute__((ext_vector_type(4)));
typedef unsigned u32x4 __attribute__((ext_vector_type(4)));
constexpr int BM = 256, BK = 64, HALF = 128, HTB = HALF * BK * 2  , STAGE_BYTES = 8 * HTB, NXCD = 8, WGM = 8;

__host__ __device__ __forceinline__ int lds_byte(int r, int c) { const int st = (r >> 4) * 2 + (c >> 5), rr = r & 15, cc = c & 31, ob = rr * 64 + cc * 2; return st * 1024 + (ob ^ (((ob >> 9) & 1) << 5)); }
__host__ __device__ __forceinline__ void stage_rc(int b, int& R, int& C) { const int st = b / 1024, sb = b % 1024, swz = sb ^ (((sb >> 9) & 1) << 5); R = (st >> 1) * 16 + swz / 64; C = (st & 1) * 32 + (swz % 64) / 2; }
__host__ __device__ __forceinline__ int perm32(int rho) { const int n = rho >> 4, i = rho & 15; return 8 * (i >> 2) + 4 * n + (i & 3); }

struct Unit { int pm, pn; };
struct Gemm { const bf16_t* A; const bf16_t* Bt; int M, N, K; };

struct StaticOrder {
    int nM, nN, nwg, G, c;
    __host__ __device__ void init(int M, int N, int G_, int c_) { nM = M / BM; nN = N / BM; nwg = nM * nN; G = G_; c = c_; }
    __host__ __device__ bool next(int i, Unit& u) const {
        const long L = (long)i * G + c; if (L >= nwg) return false;
        int wgid = (int)L; { const int q = nwg / NXCD, r = nwg % NXCD, xcd = wgid % NXCD, off = wgid / NXCD; wgid = (xcd < r ? xcd * (q + 1) : r * (q + 1) + (xcd - r) * q) + off; }
        const int nig = WGM * nN, gid = wgid / nig, fm = gid * WGM, gsz = (nM - fm) < WGM ? (nM - fm) : WGM;
        u.pm = fm + ((wgid % nig) % gsz); u.pn = (wgid % nig) / gsz; return true;
    }
    __device__ __forceinline__ void a_ready(const Unit&) const {}
    __device__ __forceinline__ void done(const Unit&) const {}
};


__device__ __forceinline__ unsigned cvt_pk_bf16(float lo, float hi) { unsigned r; asm volatile("v_cvt_pk_bf16_f32 %0, %1, %2" : "=v"(r) : "v"(lo), "v"(hi)); return r; }

struct EpiBf16S {
    static constexpr bool PERM = true, AFTER_DRAIN = false;
    bf16_t* O; int ldc; int scale_cols; float scale0;
    __device__ __forceinline__ void operator()(const f32x4 (&acc)[2][2][4][2], const Unit& u, int wr, int wc, int fr, int fq) const {
        const int row0 = u.pm * BM + wr * 64 + fr, col0 = u.pn * BM + wc * 32 + 8 * fq;
        const float sc = (u.pn * BM < scale_cols) ? scale0 : 1.0f;
#pragma unroll
        for (int ai = 0; ai < 2; ++ai)
#pragma unroll
            for (int m = 0; m < 4; ++m) { bf16_t* rowp = O + (size_t)(row0 + ai * HALF + m * 16) * ldc + col0;
#pragma unroll
                for (int bj = 0; bj < 2; ++bj) { const f32x4 v0 = acc[ai][bj][m][0] * sc, v1 = acc[ai][bj][m][1] * sc;
                    u32x4 w; w.x = cvt_pk_bf16(v0[0], v0[1]); w.y = cvt_pk_bf16(v0[2], v0[3]); w.z = cvt_pk_bf16(v1[0], v1[1]); w.w = cvt_pk_bf16(v1[2], v1[3]);
                    *(u32x4*)(rowp + bj * HALF) = w; } }
    }
};
template <bool FIRST> struct EpiGate {
    static constexpr bool PERM = true, AFTER_DRAIN = false;
    const bf16_t* gate; bf16_t* mrg;
    __device__ __forceinline__ void operator()(const f32x4 (&acc)[2][2][4][2], const Unit& u, int wr, int wc, int fr, int fq) const {
        const int row0 = u.pm * BM + wr * 64 + fr, col0 = u.pn * BM + wc * 32 + 8 * fq;
#pragma unroll
        for (int ai = 0; ai < 2; ++ai)
#pragma unroll
            for (int m = 0; m < 4; ++m) { const size_t row = (size_t)(row0 + ai * HALF + m * 16);
#pragma unroll
                for (int bj = 0; bj < 2; ++bj) {
                    const u32x4 gw = *(const u32x4*)(gate + row * INC + col0 + bj * HALF);
                    bf16_t* op = mrg + row * D + col0 + bj * HALF;
                    const f32x4 a0 = acc[ai][bj][m][0], a1 = acc[ai][bj][m][1];
                    float r[8];
                    r[0] = sigmoidf_(bflo(gw.x)) * a0[0]; r[1] = sigmoidf_(bfhi(gw.x)) * a0[1]; r[2] = sigmoidf_(bflo(gw.y)) * a0[2]; r[3] = sigmoidf_(bfhi(gw.y)) * a0[3];
                    r[4] = sigmoidf_(bflo(gw.z)) * a1[0]; r[5] = sigmoidf_(bfhi(gw.z)) * a1[1]; r[6] = sigmoidf_(bflo(gw.w)) * a1[2]; r[7] = sigmoidf_(bfhi(gw.w)) * a1[3];
                    if (!FIRST) { const u32x4 pw = *(const u32x4*)op;
                        r[0] += bflo(pw.x); r[1] += bfhi(pw.x); r[2] += bflo(pw.y); r[3] += bfhi(pw.y); r[4] += bflo(pw.z); r[5] += bfhi(pw.z); r[6] += bflo(pw.w); r[7] += bfhi(pw.w); }
                    u32x4 w; w.x = cvt_pk_bf16(r[0], r[1]); w.y = cvt_pk_bf16(r[2], r[3]); w.z = cvt_pk_bf16(r[4], r[5]); w.w = cvt_pk_bf16(r[6], r[7]);
                    *(u32x4*)op = w; } }
    }
};
struct EpiResid {
    static constexpr bool PERM = false, AFTER_DRAIN = false;
    const float* xin; const float* ada_l; float* x1;
    __device__ __forceinline__ void operator()(const f32x4 (&acc)[2][2][4][2], const Unit& u, int wr, int wc, int fr, int fq) const {
        const int row0 = u.pm * BM + wr * 64 + fr, col0 = u.pn * BM + wc * 32 + 4 * fq;
        const float* g1 = ada_l + (size_t)((u.pm * BM) / SEQ) * 6 * D + 2 * D + col0;
        f32x4 gv[2][2];
#pragma unroll
        for (int bj = 0; bj < 2; ++bj)
#pragma unroll
            for (int n = 0; n < 2; ++n) gv[bj][n] = *(const f32x4*)(g1 + bj * HALF + n * 16);
#pragma unroll
        for (int ai = 0; ai < 2; ++ai)
#pragma unroll
            for (int m = 0; m < 4; ++m) { const size_t off = (size_t)(row0 + ai * HALF + m * 16) * D + col0;
#pragma unroll
                for (int bj = 0; bj < 2; ++bj)
#pragma unroll
                    for (int n = 0; n < 2; ++n) { const f32x4 xv = *(const f32x4*)(xin + off + bj * HALF + n * 16);
                        *(f32x4*)(x1 + off + bj * HALF + n * 16) = xv + gv[bj][n] * acc[ai][bj][m][n]; } }
    }
};
template <class Epi, class Sched, bool ALIGN_EPI = false, bool SP2 = false>
__device__ __forceinline__ void gemm_phase(PG8_LAS unsigned char* lds, const Gemm g, const Sched& S, const Epi& E) {
    const int tid = laundered_tid(), wid = __builtin_amdgcn_readfirstlane(tid >> 6), lane = tid & 63, wr = wid >> 2, wc = wid & 3, fr = lane & 15, fq = lane >> 4;
    const int K = g.K, nt = K / BK;
    unsigned voffA[2], voffB[2];
#pragma unroll
    for (int i = 0; i < 2; ++i) { int R, C; stage_rc(tid * 16 + i * 8192, R, C); const int Rb = Epi::PERM ? ((R & ~31) + perm32(R & 31)) : R;
        voffA[i] = (unsigned)(R * K + C) * 2u; voffB[i] = (unsigned)(Rb * K + C) * 2u; }
    const size_t kstep = (size_t)(BK * 2);
    const size_t hstep = (size_t)HALF * K * 2;
    const size_t tstep = 2 * hstep;
    const unsigned ldsw = (unsigned)wid * 1024u;
    const int aoff = lds_byte(wr * 64 + fr, fq * 8), boff = lds_byte(wc * 32 + fr, fq * 8);
#define PG8_SA(b, h) (((b) * 2 + (h)) * HTB)
#define PG8_SB(b, h) ((4 + (b) * 2 + (h)) * HTB)
#define PG8_STAGE(bufoff, gbase, voff) do { _Pragma("unroll") for (int _i = 0; _i < 2; ++_i) \
        __builtin_amdgcn_global_load_lds((const unsigned*)((const char*)(gbase) + (voff)[_i]), (PG8_LAS unsigned*)(lds + (bufoff) + ldsw + _i * 8192), 16, 0, 0); } while (0)
#define PG8_LDA(dst, b, h) do { _Pragma("unroll") for (int m = 0; m < 4; ++m) _Pragma("unroll") for (int k = 0; k < 2; ++k) dst[m][k] = *(const PG8_LAS bf16x8*)(lds + PG8_SA(b, h) + aoff + m * 2048 + k * 1024); } while (0)
#define PG8_LDB(dst, b, h) do { _Pragma("unroll") for (int n = 0; n < 2; ++n) _Pragma("unroll") for (int k = 0; k < 2; ++k) dst[n][k] = *(const PG8_LAS bf16x8*)(lds + PG8_SB(b, h) + boff + n * 2048 + k * 1024); } while (0)
#define PG8_MMA(ai, bj, At, Bt) do { __builtin_amdgcn_s_setprio(1); _Pragma("unroll") for (int m = 0; m < 4; ++m) _Pragma("unroll") for (int n = 0; n < 2; ++n) _Pragma("unroll") for (int k = 0; k < 2; ++k) \
        acc[ai][bj][m][n] = __builtin_amdgcn_mfma_f32_16x16x32_bf16(Bt[n][k], At[m][k], acc[ai][bj][m][n], 0, 0, 0); __builtin_amdgcn_s_setprio(0); } while (0)
#define PG8_WAIT_V(n) asm volatile("s_waitcnt vmcnt(" #n ")" ::: "memory")
#define PG8_WAIT_L(n) asm volatile("s_waitcnt lgkmcnt(" #n ")" ::: "memory")
#define PG8_BAR __builtin_amdgcn_s_barrier()
#define PG8_SCHED __builtin_amdgcn_sched_barrier(0)
    Unit cur, nxt; int ui = 0;
    if (!S.next(0, cur)) return;
    f32x4 acc[2][2][4][2];
#pragma unroll
    for (int a = 0; a < 2; ++a)
#pragma unroll
        for (int b = 0; b < 2; ++b)
#pragma unroll
            for (int m = 0; m < 4; ++m)
#pragma unroll
                for (int n = 0; n < 2; ++n) acc[a][b][m][n] = (f32x4){0.f, 0.f, 0.f, 0.f};
    bf16x8 At[4][2], B0[2][2], B1[2][2];
    const char* cA = (const char*)g.A + (size_t)cur.pm * tstep; const char* cB = (const char*)g.Bt + (size_t)cur.pn * tstep;
    S.a_ready(cur);
    if constexpr (SP2) {
        PG8_STAGE(PG8_SB(0, 0), cB, voffB); PG8_STAGE(PG8_SB(0, 1), cB + hstep, voffB); PG8_STAGE(PG8_SA(0, 0), cA, voffA); PG8_STAGE(PG8_SA(0, 1), cA + hstep, voffA);
        if (wr == 1) PG8_BAR;
        PG8_WAIT_V(2); PG8_BAR;
        PG8_STAGE(PG8_SB(1, 0), cB + kstep, voffB); PG8_STAGE(PG8_SA(1, 0), cA + kstep, voffA); PG8_STAGE(PG8_SB(1, 1), cB + hstep + kstep, voffB);
        PG8_WAIT_V(6); PG8_BAR;
    } else {
        PG8_STAGE(PG8_SB(0, 0), cB, voffB); PG8_STAGE(PG8_SA(0, 0), cA, voffA); PG8_STAGE(PG8_SB(0, 1), cB + hstep, voffB); PG8_STAGE(PG8_SA(0, 1), cA + hstep, voffA);
        if (wr == 1) PG8_BAR;
        PG8_WAIT_V(4); PG8_BAR;
        PG8_STAGE(PG8_SB(1, 0), cB + kstep, voffB); PG8_STAGE(PG8_SA(1, 0), cA + kstep, voffA); PG8_STAGE(PG8_SB(1, 1), cB + hstep + kstep, voffB);
        PG8_WAIT_V(6); PG8_BAR;
    }
    for (;;) {
        const bool has_next = S.next(ui + 1, nxt);
        const char* nA = has_next ? (const char*)g.A + (size_t)nxt.pm * tstep : cA; const char* nB = has_next ? (const char*)g.Bt + (size_t)nxt.pn * tstep : cB;
        for (int t = 0; t < nt; t += 2) {
            const bool last = (t == nt - 2);
            const char* a1 = cA + (size_t)(t + 1) * kstep;
            const char* a2 = last ? nA : cA + (size_t)(t + 2) * kstep; const char* b2 = last ? nB : cB + (size_t)(t + 2) * kstep;
            const char* a3 = a2 + kstep; const char* b3 = b2 + kstep;
            if (last && has_next) S.a_ready(nxt);
            if constexpr (SP2) {
            PG8_LDB(B0, 0, 0); PG8_LDB(B1, 0, 1); PG8_SCHED; PG8_LDA(At, 0, 0); PG8_STAGE(PG8_SA(1, 1), a1 + hstep, voffA);
            PG8_WAIT_V(8); PG8_WAIT_L(0); PG8_BAR; PG8_MMA(0, 0, At, B0); PG8_MMA(0, 1, At, B1); PG8_BAR; PG8_SCHED;
            PG8_LDA(At, 0, 1); PG8_STAGE(PG8_SB(0, 0), b2, voffB); PG8_STAGE(PG8_SB(0, 1), b2 + hstep, voffB); PG8_STAGE(PG8_SA(0, 0), a2, voffA);
            PG8_WAIT_V(8); PG8_WAIT_L(0); PG8_BAR; PG8_MMA(1, 0, At, B0); PG8_MMA(1, 1, At, B1); PG8_BAR; PG8_SCHED;
            PG8_LDB(B0, 1, 0); PG8_LDB(B1, 1, 1); PG8_SCHED; PG8_LDA(At, 1, 0); PG8_STAGE(PG8_SA(0, 1), a2 + hstep, voffA);
            PG8_WAIT_V(8); PG8_WAIT_L(0); PG8_BAR; PG8_MMA(0, 0, At, B0); PG8_MMA(0, 1, At, B1); PG8_BAR; PG8_SCHED;
            PG8_LDA(At, 1, 1); PG8_STAGE(PG8_SB(1, 0), b3, voffB); PG8_STAGE(PG8_SB(1, 1), b3 + hstep, voffB); PG8_STAGE(PG8_SA(1, 0), a3, voffA);
            PG8_WAIT_V(8); PG8_WAIT_L(0); PG8_BAR; PG8_MMA(1, 0, At, B0); PG8_MMA(1, 1, At, B1); PG8_BAR; PG8_SCHED;
            } else {
            PG8_LDB(B0, 0, 0); PG8_SCHED; PG8_LDA(At, 0, 0); PG8_STAGE(PG8_SA(1, 1), a1 + hstep, voffA);
            PG8_WAIT_L(8); PG8_BAR; PG8_WAIT_L(0); PG8_MMA(0, 0, At, B0); PG8_BAR; PG8_SCHED;
            PG8_LDB(B1, 0, 1); PG8_STAGE(PG8_SB(0, 0), b2, voffB);
            PG8_BAR; PG8_WAIT_L(0); PG8_MMA(0, 1, At, B1); PG8_BAR;
            PG8_LDA(At, 0, 1); PG8_STAGE(PG8_SA(0, 0), a2, voffA);
            PG8_BAR; PG8_WAIT_L(0); PG8_MMA(1, 0, At, B0); PG8_BAR; PG8_SCHED;
            PG8_STAGE(PG8_SB(0, 1), b2 + hstep, voffB);
            PG8_WAIT_V(6); PG8_BAR; PG8_MMA(1, 1, At, B1); PG8_BAR;
            PG8_LDB(B0, 1, 0); PG8_SCHED; PG8_LDA(At, 1, 0); PG8_STAGE(PG8_SA(0, 1), a2 + hstep, voffA);
            PG8_WAIT_L(8); PG8_BAR; PG8_WAIT_L(0); PG8_MMA(0, 0, At, B0); PG8_BAR; PG8_SCHED;
            PG8_LDB(B1, 1, 1); PG8_STAGE(PG8_SB(1, 0), b3, voffB);
            PG8_BAR; PG8_WAIT_L(0); PG8_MMA(0, 1, At, B1); PG8_BAR;
            PG8_LDA(At, 1, 1); PG8_STAGE(PG8_SA(1, 0), a3, voffA);
            PG8_BAR; PG8_WAIT_L(0); PG8_MMA(1, 0, At, B0); PG8_BAR; PG8_SCHED;
            PG8_STAGE(PG8_SB(1, 1), b3 + hstep, voffB);
            PG8_WAIT_V(6); PG8_BAR; PG8_MMA(1, 1, At, B1); PG8_BAR;
            }
        }
        if constexpr (ALIGN_EPI) { if (wr == 0) PG8_BAR; }
        if constexpr (!Epi::AFTER_DRAIN) { E(acc, cur, wr, wc, fr, fq); S.done(cur); }
        if (!has_next) break;
#pragma unroll
        for (int a = 0; a < 2; ++a)
#pragma unroll
            for (int b = 0; b < 2; ++b)
#pragma unroll
                for (int m = 0; m < 4; ++m)
#pragma unroll
                    for (int n = 0; n < 2; ++n) acc[a][b][m][n] = (f32x4){0.f, 0.f, 0.f, 0.f};
        cur = nxt; cA = nA; cB = nB; ++ui;
        if constexpr (ALIGN_EPI) { if (wr == 1) PG8_BAR; }
    }
    PG8_WAIT_V(0);
    if constexpr (!ALIGN_EPI) { if (wr == 0) PG8_BAR; }
    PG8_BAR;
    if constexpr (Epi::AFTER_DRAIN) { E.fused(acc, cur, wr, wc, fr, fq, lds, wid, lane); S.done(cur); }
#undef PG8_SA
#undef PG8_SB
#undef PG8_STAGE
#undef PG8_LDA
#undef PG8_LDB
#undef PG8_MMA
#undef PG8_WAIT_V
#undef PG8_WAIT_L
#undef PG8_BAR
#undef PG8_SCHED
}
}
#include <hip/hip_bf16.h>
#include <cmath>
namespace attn_body {
using bf16=__hip_bfloat16;
using bf16x8=__attribute__((ext_vector_type(8)))short;
using s16x4=__attribute__((ext_vector_type(4)))short;
using f32x16=__attribute__((ext_vector_type(16)))float;
using u32x4=__attribute__((ext_vector_type(4)))unsigned;
constexpr int BATCH=8,NHEAD=8,SEQ=2048,D=64,PITI=5120,PITO=512;
constexpr int NW=8,QBLK=32,QB=QBLK*NW,KVBLK=64,NQB=SEQ/QB;
constexpr int ATTN_UNIT_ROWS=QB;
__device__ __forceinline__ int crow(int r,int hi){return (r&3)+8*(r>>2)+4*hi;}
#define SBAR() __builtin_amdgcn_sched_barrier(0)
__device__ __forceinline__ void cmask(f32x16&p0,f32x16&p1,int jb,int qrel,int hi){
  const float NEG=-INFINITY; int kb=64*jb+4*hi;
  #pragma unroll
  for(int r=0;r<16;++r){int kv=kb+(r&3)+8*(r>>2); if(kv>qrel)p0[r]=NEG; if(kv+32>qrel)p1[r]=NEG;}
}

constexpr int NSLOT=3, SLOTB=8192;
constexpr int LDS_K=0, LDS_V=NSLOT*SLOTB, LDS_WS=2*NSLOT*SLOTB, LDS_OST=LDS_WS+NW*64*4, LDS_BYTES=LDS_OST+NW*4096;
constexpr float C2=0.125f*1.4426950408889634f;
__device__ __forceinline__ void glds16(const void*gsrc,unsigned lds_dst){unsigned keep;
  asm volatile("s_mov_b32 %0, m0\n\ts_mov_b32 m0, %2\n\ts_nop 0\n\tglobal_load_lds_dwordx4 %1, off\n\ts_mov_b32 m0, %0":"=&s"(keep):"v"(gsrc),"s"(lds_dst):"memory");}
__device__ __forceinline__ float max3f(float a,float b,float c){float r;asm("v_max3_f32 %0, %1, %2, %3":"=v"(r):"v"(a),"v"(b),"v"(c));return r;}
__device__ __forceinline__ float max2f(float a,float b){float r;asm("v_max_f32_e32 %0, %1, %2":"=v"(r):"v"(a),"v"(b));return r;}
__device__ __forceinline__ float fadd_s(float a,float b){float r;asm("v_add_f32_e32 %0, %1, %2":"=v"(r):"v"(a),"v"(b));return r;}
__device__ __forceinline__ float fsub_s(float a,float b){float r;asm("v_sub_f32_e32 %0, %1, %2":"=v"(r):"v"(a),"v"(b));return r;}
typedef float f32x2_t __attribute__((ext_vector_type(2))); typedef __bf16 bf16x2_t __attribute__((ext_vector_type(2)));
__device__ __forceinline__ unsigned cvtpk_s(float lo,float hi){f32x2_t v={lo,hi};bf16x2_t b=__builtin_convertvector(v,bf16x2_t);return __builtin_bit_cast(unsigned,b);}
#define WAIT_BAR(N) asm volatile("s_waitcnt vmcnt(" #N ") lgkmcnt(0)\n\ts_barrier":::"memory")

__device__ __forceinline__ void qkt(f32x16&p0,f32x16&p1,const char*Kslot,const bf16x8*qr,const f32x16&negm,int r32,int hi){
  const char*kb=Kslot+hi*1024+r32*16;
  #pragma unroll
  for(int d0=0;d0<4;++d0){
    const bf16x8 b0=*reinterpret_cast<const bf16x8*>(kb+d0*2048);
    const bf16x8 b1=*reinterpret_cast<const bf16x8*>(kb+d0*2048+512);
    if(d0==0){p0=__builtin_amdgcn_mfma_f32_32x32x16_bf16(b0,qr[0],negm,0,0,0);p1=__builtin_amdgcn_mfma_f32_32x32x16_bf16(b1,qr[0],negm,0,0,0);}
    else{p0=__builtin_amdgcn_mfma_f32_32x32x16_bf16(b0,qr[d0],p0,0,0,0);p1=__builtin_amdgcn_mfma_f32_32x32x16_bf16(b1,qr[d0],p1,0,0,0);}}
}
typedef __attribute__((address_space(3))) const char* lds_cptr;
typedef short v4i16_t __attribute__((ext_vector_type(4)));
__device__ __forceinline__ void kload8(bf16x8*kf,lds_cptr kp){
  kf[0]=*(const __attribute__((address_space(3))) bf16x8*)(kp);      kf[1]=*(const __attribute__((address_space(3))) bf16x8*)(kp+512);
  kf[2]=*(const __attribute__((address_space(3))) bf16x8*)(kp+2048); kf[3]=*(const __attribute__((address_space(3))) bf16x8*)(kp+2560);
  kf[4]=*(const __attribute__((address_space(3))) bf16x8*)(kp+4096); kf[5]=*(const __attribute__((address_space(3))) bf16x8*)(kp+4608);
  kf[6]=*(const __attribute__((address_space(3))) bf16x8*)(kp+6144); kf[7]=*(const __attribute__((address_space(3))) bf16x8*)(kp+6656);
}
__device__ __forceinline__ void kload2(bf16x8*kf,lds_cptr kp,int j){ kf[2*j]=*(const __attribute__((address_space(3))) bf16x8*)(kp+j*2048); kf[2*j+1]=*(const __attribute__((address_space(3))) bf16x8*)(kp+j*2048+512); }
__device__ __forceinline__ s16x4 vtr(lds_cptr p){ return __builtin_bit_cast(s16x4,__builtin_amdgcn_ds_read_tr16_b64_v4i16((__attribute__((address_space(3))) v4i16_t*)p)); }
__device__ __forceinline__ float rowmax(const f32x16&p0,const f32x16&p1){
  float a=max3f(p0[0],p0[1],p1[0]),b=max3f(p0[2],p0[3],p1[1]);a=max3f(a,p1[2],p1[3]);
  #pragma unroll
  for(int r=4;r<16;r+=4){a=max3f(a,p0[r],p0[r+1]);b=max3f(b,p0[r+2],p0[r+3]);a=max3f(a,p1[r],p1[r+1]);b=max3f(b,p1[r+2],p1[r+3]);}
  const float m=max2f(a,b);
  auto rr=__builtin_amdgcn_permlane32_swap(__float_as_uint(m),__float_as_uint(m),false,false);
  return max2f(__uint_as_float(rr[0]),__uint_as_float(rr[1]));
}
__device__ __forceinline__ void pv(f32x16*o,int vb,bf16x8 pa0,bf16x8 pa1,bf16x8 pa2,bf16x8 pa3){
  #pragma unroll
  for(int d0=0;d0<2;++d0){s16x4 lo[4],hi[4];
    #pragma unroll
    for(int ks=0;ks<4;++ks){
      asm volatile("ds_read_b64_tr_b16 %0,%1 offset:%c2":"=&v"(lo[ks]):"v"(vb),"i"(d0*4096+ks*1024):"memory");
      asm volatile("ds_read_b64_tr_b16 %0,%1 offset:%c2":"=&v"(hi[ks]):"v"(vb),"i"(d0*4096+ks*1024+512):"memory");}
    asm volatile("s_waitcnt lgkmcnt(0)":::"memory");SBAR();
    #define PK(k) (bf16x8){lo[k][0],lo[k][1],lo[k][2],lo[k][3],hi[k][0],hi[k][1],hi[k][2],hi[k][3]}
    o[d0]=__builtin_amdgcn_mfma_f32_32x32x16_bf16(pa0,PK(0),o[d0],0,0,0);
    o[d0]=__builtin_amdgcn_mfma_f32_32x32x16_bf16(pa1,PK(1),o[d0],0,0,0);
    o[d0]=__builtin_amdgcn_mfma_f32_32x32x16_bf16(pa2,PK(2),o[d0],0,0,0);
    o[d0]=__builtin_amdgcn_mfma_f32_32x32x16_bf16(pa3,PK(3),o[d0],0,0,0);
    #undef PK
  }
}

#ifndef ATTN_STORE16
#define ATTN_STORE16(p,v) (*(u32x4*)(p)=(v))
#endif
template<int THRL> __device__ __forceinline__ void attn_unit(int b,int h,int qb,const bf16*Q,const bf16*__restrict__ K,const bf16*__restrict__ V,bf16*O,char*shm){
  const int tid=laundered_tid(),lane=tid&63,r32=lane&31,hi=lane>>5; const int wid=__builtin_amdgcn_readfirstlane(tid>>6);
  const long rowbase=(long)b*SEQ; const int q0=qb*QB;
  const bf16*Qw=Q+(rowbase+q0+wid*QBLK)*PITI+h*D;
  const bf16*Kh=K+rowbase*PITI+h*D,*Vh=V+rowbase*PITI+h*D;
  const unsigned lds0=(unsigned)(uintptr_t)shm;
  float*wsf=(float*)(shm+LDS_WS)+wid*64;
  const bf16*ksrc=Kh+(long)lane*PITI+wid*8;
  const bf16*vsrc=Vh+(long)(16*(wid&3)+(lane>>2))*PITI+(wid>>2)*32+(lane&3)*8;
  const unsigned kdst=lds0+LDS_K+wid*1024, vdst=lds0+LDS_V+wid*1024;
  #define TROW(t) (((t)<4)?(q0+KVBLK*(t)):(KVBLK*((t)-4)))
  #define DMA_K(t,slot) glds16(ksrc+(long)TROW(t)*PITI,(unsigned)__builtin_amdgcn_readfirstlane(kdst+(slot)))
  #define DMA_V(t,slot) glds16(vsrc+(long)TROW(t)*PITI,(unsigned)__builtin_amdgcn_readfirstlane(vdst+(slot)))
  const int vb0=(int)(lds0+LDS_V)+((lane>>4)&1)*32+(lane&3)*8+(4*hi+((lane&15)>>2))*64;
  const char*Kbase=shm+LDS_K; bf16x8 kf[8];
  const lds_cptr shm3=(lds_cptr)shm; const lds_cptr kp0=shm3+LDS_K+hi*1024+r32*16; const lds_cptr vp0=shm3+LDS_V+((lane>>4)&1)*32+(lane&3)*8+(4*hi+((lane&15)>>2))*64;
  const int NT=(q0+QB)/KVBLK;
  bf16x8 qr[4];
  #pragma unroll
  for(int d0=0;d0<4;++d0)qr[d0]=*reinterpret_cast<const bf16x8*>(&Qw[(long)r32*PITI+d0*16+hi*8]);
  unsigned sel=0u;
  const float s2=__builtin_amdgcn_exp2f(-(float)(h+1))*1.4426950408889634f;
  if(qb>0){
    typedef __attribute__((address_space(3))) float* lds_fptr;
    const lds_fptr ksl=(lds_fptr)((__attribute__((address_space(3))) char*)shm+LDS_BYTES);
    if(wid<qb){
      const int rsub=lane>>3,ch=lane&7; const bf16*kp=Kh+(long)(wid*256+rsub)*PITI+ch*8;
      float a8[8];
      #pragma unroll
      for(int j=0;j<8;++j)a8[j]=0.f;
      #pragma unroll 4
      for(int i=0;i<32;++i){ const u32x4 w=*reinterpret_cast<const u32x4*>(kp+(long)i*8*PITI);
        a8[0]+=__uint_as_float(w.x<<16);a8[1]+=__uint_as_float(w.x&0xffff0000u);a8[2]+=__uint_as_float(w.y<<16);a8[3]+=__uint_as_float(w.y&0xffff0000u);
        a8[4]+=__uint_as_float(w.z<<16);a8[5]+=__uint_as_float(w.z&0xffff0000u);a8[6]+=__uint_as_float(w.w<<16);a8[7]+=__uint_as_float(w.w&0xffff0000u); }
      #pragma unroll
      for(int j=0;j<8;++j){ a8[j]+=__shfl_xor(a8[j],8); a8[j]+=__shfl_xor(a8[j],16); a8[j]+=__shfl_xor(a8[j],32); }
      if(lane<8){
        #pragma unroll
        for(int j=0;j<8;++j)ksl[wid*64+ch*8+j]=a8[j]; }
    }
    __syncthreads();
    float g[7];
    #pragma unroll
    for(int n=0;n<7;++n){ float acc=0.f;
      if(n<qb){
        #pragma unroll
        for(int d0=0;d0<4;++d0)
          #pragma unroll
          for(int j=0;j<8;++j)acc+=__uint_as_float(((unsigned)(unsigned short)qr[d0][j])<<16)*ksl[n*64+16*d0+8*hi+j];
        acc+=__shfl_xor(acc,32); }
      g[n]=acc; }
    if(qb<=3)sel=(1u<<qb)-1u;
    else{
      #pragma unroll
      for(int r=0;r<3;++r){ float best=-INFINITY; int bi=0;
        #pragma unroll
        for(int n=0;n<7;++n){ if(n<qb&&!((sel>>n)&1u)&&g[n]>best){best=g[n];bi=n;} }
        sel|=1u<<bi; } }
    __syncthreads();
  }
  DMA_K(0,0);DMA_V(0,0);DMA_K(1,SLOTB);
  float mhat=0.f,l_reg=0.f;f32x16 o[2];o[0]=f32x16{};o[1]=f32x16{};const f32x16 negm=f32x16{};
  const int qrel=wid*QBLK+r32;
  #define CMASK(P0,P1,t) do{ const int t_=(t); \
      if(t_<4){ cmask(P0,P1,t_,qrel,hi); } \
      else if(!((sel>>((t_-4)>>2))&1u)){ _Pragma("unroll") for(int r=0;r<16;++r){P0[r]=-INFINITY;P1[r]=-INFINITY;} } \
      const float tb_=s2*(float)(TROW(t_)+4*hi)-mhat; \
      _Pragma("unroll") for(int r=0;r<16;++r){ P0[r]=__builtin_fmaf((float)((r&3)+8*(r>>2)),s2,P0[r])+tb_; P1[r]=__builtin_fmaf((float)(32+(r&3)+8*(r>>2)),s2,P1[r])+tb_; } }while(0)
  bool resc=false;
  #define START(P0,P1) do{ const float rm=rowmax(P0,P1); resc=false; \
    { const float dl=rm; mhat=fadd_s(mhat,dl); \
      _Pragma("unroll") for(int r=0;r<16;++r){P0[r]=fsub_s(P0[r],dl);P1[r]=fsub_s(P1[r],dl);} \
      } \
    _Pragma("unroll") for(int r=0;r<16;++r)P0[r]=__builtin_amdgcn_exp2f(P0[r]); }while(0)
  #define RESC() do{ if(resc){ asm volatile("s_waitcnt lgkmcnt(0)":::"memory"); \
      _Pragma("unroll") for(int d_=0;d_<2;++d_) _Pragma("unroll") for(int r=0;r<16;++r)o[d_][r]*=wsf[crow(r,hi)]; } }while(0)
  f32x16 pA0,pA1,pB0,pB1;
  int sl_prev=0,sl_cur=0,sl_next=SLOTB;
  #define ROT() do{sl_prev=sl_cur;sl_cur=sl_next;sl_next=(sl_next==(NSLOT-1)*SLOTB)?0:sl_next+SLOTB;}while(0)
  DMA_K(2,2*SLOTB);
  WAIT_BAR(3);
  qkt(pA0,pA1,Kbase,qr,negm,r32,hi);asm volatile("s_nop 15\n\ts_nop 7":"+v"(pA0),"+v"(pA1));CMASK(pA0,pA1,0);
  START(pA0,pA1);
  _Pragma("unroll") for(int r=0;r<16;++r)pA1[r]=__builtin_amdgcn_exp2f(pA1[r]);
  WAIT_BAR(0);
  DMA_K(3,0);DMA_V(1,SLOTB);
  ROT();
  kload8(kf,kp0+sl_cur);
  WAIT_BAR(2);
  s16x4 vlo[8],vhi[8]; u32x4 pw0,pw1,pw2,pw3;
  #define PKW(P,B) cvtpk_s(P[B],P[B+1])
  #define PAF(k) __builtin_bit_cast(bf16x8,pw##k)
  #define VFR(i) (bf16x8){vlo[i][0],vlo[i][1],vlo[i][2],vlo[i][3],vhi[i][0],vhi[i][1],vhi[i][2],vhi[i][3]}
  #define PIN(x) asm volatile("":"+v"(x))
  #define MX3(a,b,c) __builtin_fmaxf(__builtin_fmaxf((a),(b)),(c))
  #define GAPA(MF,A0,A1,A2,A3,W0,W1,PW) do{ MF; sacc+=A0; sacc+=A1; sacc+=A2; sacc+=A3; PIN(sacc); W0; W1; PIN(PW); SBAR(); }while(0)
  #define EX(v) __builtin_amdgcn_exp2f(v)
  #define GAPB(MF,X,B) do{ MF; X[B]=EX(X[B]); X[B+1]=EX(X[B+1]); X[B+2]=EX(X[B+2]); X[B+3]=EX(X[B+3]); PIN(X); SBAR(); }while(0)
  #define VRD(i) do{ vlo[i]=vtr(vp_+(((i)>>2)*4096+((i)&3)*1024)); vhi[i]=vtr(vp_+(((i)>>2)*4096+((i)&3)*1024+512)); }while(0)
  #define KRD(G,j) do{ if(G){ kload2(kf,kp0+sl_next,j); SBAR(); } }while(0)
  #define STEP(C0,C1,P0,P1,t,GK,GV,GL) do{ SBAR(); \
    const lds_cptr vp_=vp0+sl_prev; \
    VRD(0); SBAR(); float sacc=(P0[0]+P0[1]); \
    GAPA(C0=__builtin_amdgcn_mfma_f32_32x32x16_bf16(kf[0],qr[0],negm,0,0,0), P0[2],P0[3],P0[4],P0[5],     pw0[0]=PKW(P0,0), pw0[1]=PKW(P0,2), pw0); \
    VRD(4); SBAR(); GAPA(C1=__builtin_amdgcn_mfma_f32_32x32x16_bf16(kf[1],qr[0],negm,0,0,0), P0[6],P0[7],P0[8],P0[9],     pw0[2]=PKW(P0,4), pw0[3]=PKW(P0,6), pw0); \
    VRD(1); SBAR(); GAPA(C0=__builtin_amdgcn_mfma_f32_32x32x16_bf16(kf[2],qr[1],C0,0,0,0),   P0[10],P0[11],P0[12],P0[13], pw1[0]=PKW(P0,8), pw1[1]=PKW(P0,10), pw1); \
    VRD(5); SBAR(); GAPA(C1=__builtin_amdgcn_mfma_f32_32x32x16_bf16(kf[3],qr[1],C1,0,0,0),   P0[14],P0[15],P1[0],P1[1],   pw1[2]=PKW(P0,12),pw1[3]=PKW(P0,14), pw1); \
    VRD(2); SBAR(); GAPA(C0=__builtin_amdgcn_mfma_f32_32x32x16_bf16(kf[4],qr[2],C0,0,0,0),   P1[2],P1[3],P1[4],P1[5],     pw2[0]=PKW(P1,0), pw2[1]=PKW(P1,2), pw2); \
    VRD(6); SBAR(); GAPA(C1=__builtin_amdgcn_mfma_f32_32x32x16_bf16(kf[5],qr[2],C1,0,0,0),   P1[6],P1[7],P1[8],P1[9],     pw2[2]=PKW(P1,4), pw2[3]=PKW(P1,6), pw2); \
    VRD(3); SBAR(); GAPA(C0=__builtin_amdgcn_mfma_f32_32x32x16_bf16(kf[6],qr[3],C0,0,0,0),   P1[10],P1[11],P1[12],P1[13], pw3[0]=PKW(P1,8), pw3[1]=PKW(P1,10), pw3); \
    VRD(7); SBAR(); GAPA(C1=__builtin_amdgcn_mfma_f32_32x32x16_bf16(kf[7],qr[3],C1,0,0,0),   P1[14],P1[15],0.f,0.f,       pw3[2]=PKW(P1,12),pw3[3]=PKW(P1,14), pw3); \
    l_reg+=sacc; \
    if(GK){DMA_K((t)+3,sl_cur);} if(GV){DMA_V((t)+1,sl_next);} \
    CMASK(C0,C1,t); \
    { float a=MX3(C0[0],C0[1],C1[0]),b=MX3(C0[2],C0[3],C1[1]); a=MX3(a,C1[2],C1[3]); \
      _Pragma("unroll") for(int r=4;r<16;r+=4){a=MX3(a,C0[r],C0[r+1]);b=MX3(b,C0[r+2],C0[r+3]);a=MX3(a,C1[r],C1[r+1]);b=MX3(b,C1[r+2],C1[r+3]);} \
      float rm=__builtin_fmaxf(a,b); { auto rr=__builtin_amdgcn_permlane32_swap(__float_as_uint(rm),__float_as_uint(rm),false,false); rm=__builtin_fmaxf(__uint_as_float(rr[0]),__uint_as_float(rr[1])); } \
      resc=false; \
      if(__builtin_expect(__any(rm>(float)THRL),0)){ const float dl=__builtin_fmaxf(rm,0.f); mhat+=dl; \
        _Pragma("unroll") for(int r=0;r<16;++r){C0[r]-=dl;C1[r]-=dl;} \
        const float f=__builtin_amdgcn_exp2f(-dl); l_reg*=f; if(hi==0)wsf[r32]=f; resc=true; } } \
    SBAR(); \
    GAPB(o[0]=__builtin_amdgcn_mfma_f32_32x32x16_bf16(PAF(0),VFR(0),o[0],0,0,0), C0,0); \
    GAPB(o[1]=__builtin_amdgcn_mfma_f32_32x32x16_bf16(PAF(0),VFR(4),o[1],0,0,0), C0,4); \
    KRD(GL,0); GAPB(o[0]=__builtin_amdgcn_mfma_f32_32x32x16_bf16(PAF(1),VFR(1),o[0],0,0,0), C0,8); \
    KRD(GL,1); GAPB(o[1]=__builtin_amdgcn_mfma_f32_32x32x16_bf16(PAF(1),VFR(5),o[1],0,0,0), C0,12); \
    KRD(GL,2); GAPB(o[0]=__builtin_amdgcn_mfma_f32_32x32x16_bf16(PAF(2),VFR(2),o[0],0,0,0), C1,0); \
    KRD(GL,3); GAPB(o[1]=__builtin_amdgcn_mfma_f32_32x32x16_bf16(PAF(2),VFR(6),o[1],0,0,0), C1,4); \
    GAPB(o[0]=__builtin_amdgcn_mfma_f32_32x32x16_bf16(PAF(3),VFR(3),o[0],0,0,0), C1,8); \
    GAPB(o[1]=__builtin_amdgcn_mfma_f32_32x32x16_bf16(PAF(3),VFR(7),o[1],0,0,0), C1,12); \
    }while(0)
  int t=1;
  for(;t+5<NT;t+=2){
    STEP(pB0,pB1,pA0,pA1,t,true,true,true);     WAIT_BAR(2); RESC(); ROT();
    STEP(pA0,pA1,pB0,pB1,t+1,true,true,true);   WAIT_BAR(2); RESC(); ROT();
  }
  #define ENDW(tt) do{ if((tt)+3<NT){WAIT_BAR(2);} else if((tt)+2<NT){WAIT_BAR(1);} else {WAIT_BAR(0);} }while(0)
  for(;t+1<NT;t+=2){
    STEP(pB0,pB1,pA0,pA1,t,(t+3<NT),(t+1<NT),(t+1<NT));       ENDW(t);   RESC(); ROT();
    STEP(pA0,pA1,pB0,pB1,t+1,(t+4<NT),(t+2<NT),(t+2<NT));     ENDW(t+1); RESC(); ROT();
  }
  STEP(pB0,pB1,pA0,pA1,NT-1,false,false,false); RESC();
  { float sacc=pB0[0]+pB0[1]; _Pragma("unroll") for(int r=2;r<16;++r)sacc+=pB0[r]; _Pragma("unroll") for(int r=0;r<16;++r)sacc+=pB1[r]; l_reg+=sacc;
    pw0=(u32x4){PKW(pB0,0),PKW(pB0,2),PKW(pB0,4),PKW(pB0,6)};pw1=(u32x4){PKW(pB0,8),PKW(pB0,10),PKW(pB0,12),PKW(pB0,14)};pw2=(u32x4){PKW(pB1,0),PKW(pB1,2),PKW(pB1,4),PKW(pB1,6)};pw3=(u32x4){PKW(pB1,8),PKW(pB1,10),PKW(pB1,12),PKW(pB1,14)};
    SBAR(); pv(o,vb0+sl_cur,PAF(0),PAF(1),PAF(2),PAF(3)); }
  #undef PKW
  #undef PAF
  #undef VFR
  #undef PIN
  #undef MX3
  #undef GAPA
  #undef GAPB
  #undef EX
  #undef VRD
  #undef KRD
  #undef STEP
  #undef ENDW
  {auto rr=__builtin_amdgcn_permlane32_swap(__float_as_uint(l_reg),__float_as_uint(l_reg),false,false);l_reg=__uint_as_float(rr[0])+__uint_as_float(rr[1]);}
  if(hi==0)wsf[32+r32]=l_reg;asm volatile("s_waitcnt lgkmcnt(0)":::"memory");
  float rli[16];
  #pragma unroll
  for(int r=0;r<16;++r)rli[r]=__builtin_amdgcn_rcpf(wsf[32+crow(r,hi)]);
  bf16*Ow=O+(rowbase+q0+wid*QBLK)*PITO+h*D;
  { bf16*stg=(bf16*)(shm+LDS_OST)+wid*2048;
    #pragma unroll
    for(int r=0;r<16;++r){const int orow=crow(r,hi);
      #pragma unroll
      for(int d0=0;d0<2;++d0)stg[orow*64+d0*32+r32]=__float2bfloat16(o[d0][r]*rli[r]);}
    asm volatile("s_waitcnt lgkmcnt(0)":::"memory");
    #pragma unroll
    for(int i=0;i<4;++i){const int row=i*8+(lane>>3),ch=lane&7; const u32x4 v=*(const u32x4*)(stg+row*64+ch*8); ATTN_STORE16(Ow+(long)row*PITO+ch*8,v);} }
  asm volatile("s_waitcnt lgkmcnt(0)\n\ts_barrier":::"memory");
  #undef DMA_K
  #undef DMA_V
  #undef CMASK
  #undef START
  #undef RESC
  #undef ROT
}
constexpr int ATTN_LDS_BYTES=LDS_BYTES;
template<int THRL=8> __device__ __forceinline__ void attn_phase(char*lds,const bf16*proj,bf16*ya,int vcu,int G){
  for(int u=vcu;u<512;u+=G){ const int bh=(u&255)>>2,s=u&3,qb=(u<256)?7-s:s;
    attn_unit<THRL>(bh/NHEAD,bh%NHEAD,qb,proj,proj+512,proj+1024,ya,lds); }
}
#undef SBAR
#undef WAIT_BAR
}

constexpr int NWAVES = 8;
constexpr int RING_OFF = 0, RING_BYTES = 131072;
constexpr int LDSCTL_OFF = RING_BYTES, MISC_OFF = LDSCTL_OFF + 320;
constexpr int LDS_BYTES = 147456;
constexpr int CW_BAR = 4096;

typedef unsigned v4u __attribute__((ext_vector_type(4)));
typedef unsigned v2u __attribute__((ext_vector_type(2)));
typedef float f32x4 __attribute__((ext_vector_type(4)));
typedef GAS unsigned gu32;
#define RLX_AGENT __ATOMIC_RELAXED, __HIP_MEMORY_SCOPE_AGENT
#define LDS_WAIT() asm volatile("s_waitcnt lgkmcnt(0)" ::: "memory")
#define VM_WAIT() asm volatile("s_waitcnt vmcnt(0)" ::: "memory")

#define XB_TMO      128
#define XB_XCNT(j)  (256  + 64 * (j))
#define XB_XSUB(j)  (1280 + 64 * (j))
#define XB_XGEN(j)  (2304 + 64 * (j))
#define XB_TOP      3328
#define XB_TOPGEN   3392
#define XCD_BAR_WORDS 3456
#define XB_SPIN_CAP (1u << 22)
__device__ __forceinline__ unsigned xb_ld(unsigned* p)              { return __hip_atomic_load(p, __ATOMIC_RELAXED, __HIP_MEMORY_SCOPE_AGENT); }
__device__ __forceinline__ unsigned xb_add(unsigned* p, unsigned v) { return __hip_atomic_fetch_add(p, v, __ATOMIC_RELAXED, __HIP_MEMORY_SCOPE_AGENT); }
__device__ __forceinline__ unsigned xb_xcc_id() { return (unsigned)__builtin_amdgcn_s_getreg((3 << 11) | 20) & 0xFu; }
#define XB_SPIN(cond, bar) do { unsigned _sp = 0; while (cond) { __builtin_amdgcn_s_sleep(1); \
    if ((++_sp & 255u) == 0u) { if (xb_ld(&(bar)[XB_TMO])) break; if (_sp > XB_SPIN_CAP) { atomicAdd(&(bar)[XB_TMO], 1u); break; } } } } while (0)
struct XcdBarrier { unsigned* bar; unsigned x; volatile LAS unsigned* st; };
__device__ __forceinline__ XcdBarrier xcd_barrier_post(unsigned* bar, volatile LAS unsigned* st) {
    XcdBarrier b; b.bar = bar; b.x = xb_xcc_id(); b.st = st;
    if (threadIdx.x == 0) (void)xb_add(&bar[XB_XCNT(b.x)], 1u);
    return b;
}
__device__ __forceinline__ void xcd_barrier_complete(unsigned* bar, unsigned x, unsigned& nloc, unsigned& nx) {
    const unsigned G = gridDim.x * gridDim.y * gridDim.z;
    unsigned sum, cnt, mine, sp = 0u;
    for (;;) {
        sum = 0u; cnt = 0u; mine = 0u;
#pragma unroll
        for (unsigned j = 0; j < 16; ++j) { const unsigned c = xb_ld(&bar[XB_XCNT(j)]); sum += c; cnt += (c > 0u) ? 1u : 0u; mine = (j == x) ? c : mine; }
        if (sum == G) break;
        __builtin_amdgcn_s_sleep(1);
        if ((++sp & 255u) == 0u) { if (xb_ld(&bar[XB_TMO])) break; if (sp > XB_SPIN_CAP) { atomicAdd(&bar[XB_TMO], 1u); break; } }
    }
    nloc = mine > 0u ? mine : 1u; nx = cnt > 0u ? cnt : 1u;
}
__device__ __forceinline__ void xcd_barrier(const XcdBarrier& b) {
    asm volatile("s_waitcnt vmcnt(0)" ::: "memory");
    __syncthreads();
    if (threadIdx.x == 0) {
        unsigned* bar = b.bar;
        __builtin_amdgcn_s_waitcnt(0);
        unsigned nloc = b.st[0], nx = b.st[1];
        if (nloc == 0u) { xcd_barrier_complete(bar, b.x, nloc, nx); b.st[0] = nloc; b.st[1] = nx; }
        const unsigned old = xb_add(&bar[XB_XSUB(b.x)], 1u);
        const unsigned gen = old / nloc;
        if (old + 1u == (gen + 1u) * nloc) {
            __builtin_amdgcn_fence(__ATOMIC_RELEASE, "agent");
            asm volatile("s_waitcnt vmcnt(0)" ::: "memory");
            const unsigned og = xb_add(&bar[XB_TOP], 1u);
            const unsigned tg = og / nx;
            if (og + 1u == (tg + 1u) * nx) xb_add(&bar[XB_TOPGEN], 1u);
            else XB_SPIN(xb_ld(&bar[XB_TOPGEN]) == tg, bar);
            __builtin_amdgcn_fence(__ATOMIC_ACQUIRE, "agent");
            xb_add(&bar[XB_XGEN(b.x)], 1u);
            asm volatile("s_waitcnt vmcnt(0)" ::: "memory");
        } else {
            XB_SPIN(xb_ld(&bar[XB_XGEN(b.x)]) == gen, bar);
            __builtin_amdgcn_fence(__ATOMIC_ACQUIRE, "agent");
            asm volatile("s_waitcnt vmcnt(0)" ::: "memory");
        }
    }
    __syncthreads();
}

struct Frame {
    LAS unsigned char* lds;
    int tid, lane, wave, vcu, G;
};

__device__ __forceinline__ void p0_transpose_item(const float* W, int K, int N, bf16_t* WT, LAS float* scr, int item, int lane) {
    const int nblk = N / 32, kb = item / nblk, nb = item % nblk, k0 = 64 * kb, n0 = 32 * nb;
#pragma unroll 8
    for (int i = 0; i < 32; ++i) { const int kk = 2 * i + (lane >> 5); scr[kk * 33 + (lane & 31)] = W[(size_t)(k0 + kk) * N + n0 + (lane & 31)]; }
    LDS_WAIT(); asm volatile("" ::: "memory");
    const int c = lane & 7;
#pragma unroll
    for (int j = 0; j < 4; ++j) { const int n = (lane >> 3) + 8 * j; const LAS float* s = scr + (8 * c) * 33 + n;
        v4u o; o.x = pk2(s[0 * 33], s[1 * 33]); o.y = pk2(s[2 * 33], s[3 * 33]); o.z = pk2(s[4 * 33], s[5 * 33]); o.w = pk2(s[6 * 33], s[7 * 33]);
        *(GAS v4u*)(WT + (size_t)(n0 + n) * K + k0 + 8 * c) = o; }
    LDS_WAIT(); asm volatile("" ::: "memory");
}
__device__ __forceinline__ void p0_cvt_item(const float* src, bf16_t* dst, size_t item, int lane) {
    const GAS f32x4* s = (const GAS f32x4*)(src + item * 2048) + lane;
    f32x4 v[8];
#pragma unroll
    for (int j = 0; j < 8; ++j) v[j] = __builtin_nontemporal_load(s + 64 * j);
    GAS v2u* d = (GAS v2u*)(dst + item * 2048) + lane;
#pragma unroll
    for (int j = 0; j < 8; ++j) { v2u o; o.x = pk2(v[j].x, v[j].y); o.y = pk2(v[j].z, v[j].w); d[64 * j] = o; }
}
__device__ __forceinline__ void p0_fp8_row(const float* src, unsigned char* dst, float* scale_out, int lane) {
    const GAS f32x4* s = (const GAS f32x4*)src + lane;
    f32x4 v[4]; float am = 0.f;
#pragma unroll
    for (int j = 0; j < 4; ++j) { v[j] = __builtin_nontemporal_load(s + 64 * j); am = fmaxf(fmaxf(am, fmaxf(fabsf(v[j].x), fabsf(v[j].y))), fmaxf(fabsf(v[j].z), fabsf(v[j].w))); }
    am = wave_max(am);
    const float inv = am > 0.f ? 440.0f / am : 0.f;
#pragma unroll
    for (int j = 0; j < 4; ++j) { int w = 0; w = __builtin_amdgcn_cvt_pk_fp8_f32(v[j].x * inv, v[j].y * inv, w, false); w = __builtin_amdgcn_cvt_pk_fp8_f32(v[j].z * inv, v[j].w * inv, w, true);
        *(GAS unsigned*)(dst + 256 * j + 4 * lane) = (unsigned)w; }
    if (lane == 0) *scale_out = am * (1.0f / 440.0f);
}
struct P0Args { const float *c, *w_ada, *b_ada, *w_in, *w_ap, *w_cp, *w_out, *w_q, *sk, *eu, *ev; unsigned char* ws; };
__device__ __forceinline__ void p0_prologue(const Frame& F, const P0Args& a) {
    LAS float* scr = (LAS float*)(F.lds + RING_OFF + F.wave * 16384);
    const int gw = F.vcu * NWAVES + F.wave, NGW = F.G * NWAVES;
    {
        constexpr int NB = 6 * D / 64, KLEN = D / NWAVES;
        float* ada = (float*)(a.ws + WS_ADA);
        LAS float* red = (LAS float*)(F.lds + RING_OFF + F.wave * 16384 + 12288);
        for (int it = F.vcu; it < DEPTH * NB; it += F.G) {
            const int l = it / NB, nb = it % NB, n = nb * 64 + F.lane, k0 = F.wave * KLEN;
            const float* w = a.w_ada + (size_t)l * D * 6 * D + (size_t)k0 * 6 * D + n;
            float acc[BATCH];
#pragma unroll
            for (int b = 0; b < BATCH; ++b) acc[b] = 0.f;
#pragma unroll 8
            for (int k = 0; k < KLEN; ++k) { const float wv = w[(size_t)k * 6 * D];
#pragma unroll
                for (int b = 0; b < BATCH; ++b) acc[b] += a.c[b * D + k0 + k] * wv; }
#pragma unroll
            for (int b = 0; b < BATCH; ++b) red[b * 64 + F.lane] = acc[b];
            __syncthreads();
            { const int b = F.wave; float sum = a.b_ada[l * 6 * D + n];
#pragma unroll
              for (int w2 = 0; w2 < NWAVES; ++w2) sum += ((LAS float*)(F.lds + RING_OFF + w2 * 16384 + 12288))[b * 64 + F.lane];
              ada[((size_t)l * BATCH + b) * 6 * D + n] = sum; }
            __syncthreads();
        }
    }
    {
        constexpr int I_IN = (D / 64) * (INC / 32), I_AP = (512 / 64) * (D / 32), I_OUT = (D / 64) * (D / 32), I_Q = (D / 64) * (QPW / 32);
        constexpr int PER_L = I_IN + 2 * I_AP + I_OUT + I_Q;
        for (int it = gw; it < DEPTH * PER_L; it += NGW) {
            const int l = it / PER_L; int r = it % PER_L;
            if (r < I_IN) { p0_transpose_item(a.w_in + (size_t)l * D * INC, D, INC, (bf16_t*)(a.ws + WS_WIN) + (size_t)l * INC * D, scr, r, F.lane); continue; } r -= I_IN;
            if (r < I_AP) { p0_transpose_item(a.w_ap + (size_t)l * 512 * D, 512, D, (bf16_t*)(a.ws + WS_WAP) + (size_t)l * D * 512, scr, r, F.lane); continue; } r -= I_AP;
            if (r < I_AP) { p0_transpose_item(a.w_cp + (size_t)l * 512 * D, 512, D, (bf16_t*)(a.ws + WS_WCP) + (size_t)l * D * 512, scr, r, F.lane); continue; } r -= I_AP;
            if (r < I_OUT) { p0_transpose_item(a.w_out + (size_t)l * D * D, D, D, (bf16_t*)(a.ws + WS_WOUT) + (size_t)l * D * D, scr, r, F.lane); continue; } r -= I_OUT;
            p0_transpose_item(a.w_q + (size_t)l * D * QPW, D, QPW, (bf16_t*)(a.ws + WS_WQ) + (size_t)l * QPW * D, scr, r, F.lane);
        }
    }
    {
        constexpr size_t I_SK = (size_t)DEPTH * 16 * NKEY * HALFK / 2048;
        for (size_t it = gw; it < I_SK; it += NGW) p0_cvt_item(a.sk, (bf16_t*)(a.ws + WS_SK), it, F.lane);
        constexpr int NROWS = 2 * DEPTH * NEXP;
        for (int r = gw; r < NROWS; r += NGW) {
            const bool isv = r >= DEPTH * NEXP; const int rr = isv ? r - DEPTH * NEXP : r;
            p0_fp8_row((isv ? a.ev : a.eu) + (size_t)rr * D, a.ws + (isv ? WS_EV : WS_EU) + (size_t)rr * D, (float*)(a.ws + (isv ? WS_ESV : WS_ESU)) + rr, F.lane);
        }
    }
}

__device__ __forceinline__ void norm_row(const float* xr, const float* g, const float* sh, const float* sc, bf16_t* orow, int lane) {
    const GAS f32x4* xp = (const GAS f32x4*)xr + lane;
    f32x4 v[4]; float ss = 0.f;
#pragma unroll
    for (int j = 0; j < 4; ++j) { v[j] = xp[64 * j]; ss += (v[j].x * v[j].x + v[j].y * v[j].y) + (v[j].z * v[j].z + v[j].w * v[j].w); }
    const float r = rsqrtf(wave_sum(ss) * (1.0f / D) + EPS);
    GAS v2u* o8 = (GAS v2u*)orow + lane;
#pragma unroll
    for (int j = 0; j < 4; ++j) {
        const f32x4 gv = *((const f32x4*)g + lane + 64 * j), sv = *((const f32x4*)sc + lane + 64 * j), hv = *((const f32x4*)sh + lane + 64 * j);
        const f32x4 y = v[j] * r * gv * (sv + 1.0f) + hv;
        v2u o; o.x = pk2(y.x, y.y); o.y = pk2(y.z, y.w); o8[64 * j] = o; }
}
__device__ __forceinline__ void norm_phase(const Frame& F, const float* x, const float* g, const float* ada_l, int sh_off, int sc_off, bf16_t* H) {
    const int gw = F.vcu * NWAVES + F.wave, NGW = F.G * NWAVES;
    for (int m = gw; m < M; m += NGW) { const float* ab = ada_l + (size_t)(m / SEQ) * 6 * D; norm_row(x + (size_t)m * D, g, ab + sh_off, ab + sc_off, H + (size_t)m * D, F.lane); }
}

__device__ __forceinline__ void conv_phase(const Frame& F, const bf16_t* proj, const float* cw, bf16_t* yc) {
    const int gw = F.vcu * NWAVES + F.wave, NGW = F.G * NWAVES, ch0 = F.lane * 8;
    float w0[8], w1[8], w2[8];
#pragma unroll
    for (int j = 0; j < 8; ++j) { w0[j] = cw[ch0 + j]; w1[j] = cw[512 + ch0 + j]; w2[j] = cw[1024 + ch0 + j]; }
    for (int m = gw; m < M; m += NGW) {
        const int t = m % SEQ; const bf16_t* pr = proj + (size_t)m * INC;
        const v4u bg = *(const v4u*)(pr + OBG + ch0);
        const v4u c2 = *(const v4u*)(pr + OCG + ch0), h2 = *(const v4u*)(pr + OHC + ch0);
        v4u c1 = (v4u){0u, 0u, 0u, 0u}, h1 = c1, c0 = c1, h0 = c1;
        if (t >= 1) { c1 = *(const v4u*)(pr - INC + OCG + ch0); h1 = *(const v4u*)(pr - INC + OHC + ch0); }
        if (t >= 2) { c0 = *(const v4u*)(pr - 2 * INC + OCG + ch0); h0 = *(const v4u*)(pr - 2 * INC + OHC + ch0); }
        float y[8];
#pragma unroll
        for (int q = 0; q < 4; ++q) {
            y[2 * q]     = bflo(bg[q]) * (w0[2 * q] * bflo(c0[q]) * bflo(h0[q]) + w1[2 * q] * bflo(c1[q]) * bflo(h1[q]) + w2[2 * q] * bflo(c2[q]) * bflo(h2[q]));
            y[2 * q + 1] = bfhi(bg[q]) * (w0[2 * q + 1] * bfhi(c0[q]) * bfhi(h0[q]) + w1[2 * q + 1] * bfhi(c1[q]) * bfhi(h1[q]) + w2[2 * q + 1] * bfhi(c2[q]) * bfhi(h2[q]));
        }
        v4u o; o.x = pk2(y[0], y[1]); o.y = pk2(y[2], y[3]); o.z = pk2(y[4], y[5]); o.w = pk2(y[6], y[7]);
        *(v4u*)(yc + (size_t)m * 512 + ch0) = o;
    }
}

#if !USE_NAIVE_AT
__device__ __forceinline__ void attn_phase_all(const Frame& F, const bf16_t* proj, bf16_t* ya) {
    static_assert(attn_body::ATTN_LDS_BYTES + 2048 <= RING_BYTES, "attention scratch fits the ring region");
    attn_body::attn_phase<8>((char*)(F.lds + RING_OFF), (const attn_body::bf16*)proj, (attn_body::bf16*)ya, F.vcu, F.G);
}
#endif

#if !USE_NAIVE_TK
namespace tk {
typedef short bf16x8 __attribute__((ext_vector_type(8)));
typedef float f32x16 __attribute__((ext_vector_type(16)));
__device__ __forceinline__ unsigned umax_(unsigned a, unsigned b) { return a > b ? a : b; }
__device__ __forceinline__ unsigned umin_(unsigned a, unsigned b) { return a < b ? a : b; }
template <unsigned TAGMASK> __device__ __forceinline__ unsigned f2key(float f, unsigned tag) { unsigned u = __float_as_uint(f); u = (u & 0x80000000u) ? ~u : (u | 0x80000000u); return (u & ~TAGMASK) | tag; }
template <unsigned TAGMASK> __device__ __forceinline__ float key2f(unsigned k) { unsigned v = k & ~TAGMASK; v = (v & 0x80000000u) ? (v & 0x7fffffffu) : ~v; return __uint_as_float(v); }
template <int O> __device__ __forceinline__ void sort16(unsigned (&v)[64]) {
#pragma unroll
    for (int k = 2; k <= 16; k <<= 1)
#pragma unroll
        for (int j = k >> 1; j > 0; j >>= 1)
#pragma unroll
            for (int i = 0; i < 16; ++i) { const int l = i ^ j; if (l > i) { const unsigned mx = umax_(v[O + i], v[O + l]), mn = umin_(v[O + i], v[O + l]); const bool desc = ((i & k) == 0); v[O + i] = desc ? mx : mn; v[O + l] = desc ? mn : mx; } }
}
template <int O> __device__ __forceinline__ void bitonic_merge16(unsigned (&v)[64]) {
#pragma unroll
    for (int j = 8; j > 0; j >>= 1)
#pragma unroll
        for (int i = 0; i < 16; ++i) { const int l = i ^ j; if (l > i) { const unsigned mx = umax_(v[O + i], v[O + l]), mn = umin_(v[O + i], v[O + l]); v[O + i] = mx; v[O + l] = mn; } }
}
template <int A, int B> __device__ __forceinline__ void merge_top16(unsigned (&v)[64]) {
#pragma unroll
    for (int i = 0; i < 16; ++i) v[A + i] = umax_(v[A + i], v[B + 15 - i]);
    bitonic_merge16<A>(v);
}
__device__ __forceinline__ void top16_of_64(unsigned (&v)[64]) {
    sort16<0>(v); sort16<16>(v); sort16<32>(v); sort16<48>(v);
    merge_top16<0, 16>(v); merge_top16<32, 48>(v); merge_top16<0, 32>(v);
}
__device__ __forceinline__ void merge_halves(unsigned (&v)[64]) {
#pragma unroll
    for (int i = 0; i < 16; ++i) { auto rr = __builtin_amdgcn_permlane32_swap(v[i], v[i], false, false); v[16 + i] = rr[0]; v[32 + i] = rr[1]; }
#pragma unroll
    for (int i = 0; i < 16; ++i) v[i] = umax_(v[16 + i], v[32 + 15 - i]);
    bitonic_merge16<0>(v);
}
__device__ __forceinline__ int crow(int r, int hi) { return (r & 3) + 8 * (r >> 2) + 4 * hi; }

__device__ __forceinline__ void group_top16(const bf16_t* qp, const bf16_t* sk, int row0, int gp, int r32, int hi, unsigned (&out)[16]) {
    bf16x8 bq[8];
    const bf16_t* qrow = qp + (size_t)(row0 + r32) * QPW + gp * 128 + hi * 8;
#pragma unroll
    for (int ks = 0; ks < 8; ++ks) bq[ks] = *(const bf16x8*)(qrow + ks * 16);
    unsigned v[64];
#pragma unroll
    for (int kb = 0; kb < 4; ++kb) {
        unsigned koff = (unsigned)((gp * 128 + kb * 32 + r32) * HALFK + hi * 8);
        asm volatile("" : "+v"(koff));
        const bf16_t* krow = sk + koff;
        f32x16 acc = f32x16{};
#pragma unroll
        for (int ks = 0; ks < 8; ++ks) { const bf16x8 a = *(const bf16x8*)(krow + ks * 16); acc = __builtin_amdgcn_mfma_f32_32x32x16_bf16(a, bq[ks], acc, 0, 0, 0); }
#pragma unroll
        for (int r = 0; r < 16; ++r) v[kb * 16 + r] = f2key<0x7fu>(acc[r], 127u - (unsigned)(kb * 32 + crow(r, hi)));
    }
    top16_of_64(v);
    merge_halves(v);
#pragma unroll
    for (int i = 0; i < 16; ++i) out[i] = v[i];
}
constexpr int cand_before(int i) { int s = 0; for (int a = 0; a < i; ++a) s += 16 / (a + 1); return s; }
}

__device__ __forceinline__ void topk_phase(const Frame& F, const bf16_t* qp, const bf16_t* sk, int* eidx, float* egate) {
    const int gw = F.vcu * NWAVES + F.wave, NGW = F.G * NWAVES, r32 = F.lane & 31, hi = F.lane >> 5;
    for (int it = gw; it < (M / 32) * PH; it += NGW) {
        const int tile = it >> 3, hh = it & 7, row0 = tile * 32;
        unsigned L0[16], L1[16];
        tk::group_top16(qp, sk, row0, 2 * hh, r32, hi, L0);
        tk::group_top16(qp, sk, row0, 2 * hh + 1, r32, hi, L1);
        float f0[16], f1[16]; unsigned long long p0lo = 0ull, p0hi = 0ull, p1lo = 0ull, p1hi = 0ull;
#pragma unroll
        for (int i = 0; i < 16; ++i) {
            f0[i] = tk::key2f<0x7fu>(L0[i]); f1[i] = tk::key2f<0x7fu>(L1[i]);
            const unsigned long long i0 = 127u - (L0[i] & 127u), i1 = 127u - (L1[i] & 127u);
            if (i < 8) { p0lo |= i0 << (8 * i); p1lo |= i1 << (8 * i); } else { p0hi |= i0 << (8 * (i - 8)); p1hi |= i1 << (8 * (i - 8)); }
        }
        unsigned cv[64];
#pragma unroll
        for (int q = 0; q < 64; ++q) cv[q] = 0u;
#pragma unroll
        for (int i = 0; i < 16; ++i)
#pragma unroll
            for (int j = 0; j < 16; ++j) if ((i + 1) * (j + 1) <= 16) cv[tk::cand_before(i) + j] = tk::f2key<0xffu>(f0[i] + f1[j], 255u - (unsigned)(i * 16 + j));
        tk::top16_of_64(cv);
        float bv[16], sum = 0.f; int ex[16];
        const float mx = tk::key2f<0xffu>(cv[0]);
#pragma unroll
        for (int r = 0; r < 16; ++r) {
            bv[r] = __expf(tk::key2f<0xffu>(cv[r]) - mx); sum += bv[r];
            const unsigned pos = 255u - (cv[r] & 255u), i = pos >> 4, j = pos & 15u;
            const unsigned e0 = (unsigned)(((i < 8u) ? p0lo : p0hi) >> (8u * (i & 7u))) & 127u;
            const unsigned e1 = (unsigned)(((j < 8u) ? p1lo : p1hi) >> (8u * (j & 7u))) & 127u;
            ex[r] = (int)(e0 * NKEY + e1);
        }
        const float inv = __builtin_amdgcn_rcpf(sum);
        int eo[8]; float go[8];
#pragma unroll
        for (int k = 0; k < 8; ++k) { eo[k] = hi ? ex[8 + k] : ex[k]; go[k] = (hi ? bv[8 + k] : bv[k]) * inv; }
        const size_t ob = (size_t)(row0 + r32) * 128 + hh * 16 + 8 * hi;
        *(int4*)(eidx + ob) = make_int4(eo[0], eo[1], eo[2], eo[3]); *(int4*)(eidx + ob + 4) = make_int4(eo[4], eo[5], eo[6], eo[7]);
        *(float4*)(egate + ob) = make_float4(go[0], go[1], go[2], go[3]); *(float4*)(egate + ob + 4) = make_float4(go[4], go[5], go[6], go[7]);
    }
}
#endif

#if !USE_NAIVE_PE
namespace pe {
typedef __bf16 bf16x2v __attribute__((ext_vector_type(2)));
typedef float f32x2 __attribute__((ext_vector_type(2)));
__device__ __forceinline__ unsigned umax_(unsigned a, unsigned b) { return a > b ? a : b; }
__device__ __forceinline__ unsigned umin_(unsigned a, unsigned b) { return a < b ? a : b; }
__device__ __forceinline__ void sort128(unsigned (&v)[8], int i) {
#pragma unroll
    for (int k = 2; k <= 128; k <<= 1)
#pragma unroll
        for (int j = k >> 1; j > 0; j >>= 1) {
            if (j < 8) {
#pragma unroll
                for (int r = 0; r < 8; ++r) { const int q = r ^ j; if (q > r) {
                    const unsigned lo = umin_(v[r], v[q]), hi = umax_(v[r], v[q]);
                    const bool asc = (k < 8) ? ((r & k) == 0) : ((i & (k >> 3)) == 0);
                    v[r] = asc ? lo : hi; v[q] = asc ? hi : lo; } }
            } else {
                const int m = j >> 3; const bool lower = (i & m) == 0, asc = (i & (k >> 3)) == 0, keepmin = (lower == asc);
#pragma unroll
                for (int r = 0; r < 8; ++r) { const unsigned o = (unsigned)__shfl_xor((int)v[r], m); v[r] = keepmin ? umin_(v[r], o) : umax_(v[r], o); }
            }
        }
}
struct URow { v4u u[4]; float su, gs; };
struct VRow { v4u v[4]; };
__device__ __forceinline__ float group_sum16(float d) { d += __shfl_xor(d, 1); d += __shfl_xor(d, 2); d += __shfl_xor(d, 4); d += __shfl_xor(d, 8); return d; }
}

__device__ __forceinline__ void peer_phase(const Frame& F, int l, const bf16_t* H, const float* x1, const int* eidx, const float* egate, const unsigned char* eu, const unsigned char* ev, const float* esu, const float* esv, const float* ada_l, const float* final_g, float* out, const float* nx_g, const float* nx_ada, bf16_t* Hn) {
    const int gw = F.vcu * NWAVES + F.wave, lane = F.lane, g = lane >> 4;
    const bool fin = (l == DEPTH - 1);
    for (int row0 = gw * 8; row0 < M; row0 += F.G * NWAVES * 8)
#pragma unroll 1
    for (int rnd = 0; rnd < 2; ++rnd) {
        int il_ = lane & 15; asm volatile("" : "+v"(il_));
        const int i = il_, row = row0 + 4 * rnd + g;
        unsigned key[8]; float ck[8];
#pragma unroll
        for (int r = 0; r < 8; ++r) { const int x = r * 16 + i; key[r] = ((unsigned)eidx[(size_t)row * 128 + x] << 7) | (unsigned)x; ck[r] = 0.f; }
#ifndef PE_SKIP_SORT
        pe::sort128(key, i);
#endif
        {
            unsigned hh[32];
#pragma unroll
            for (int k = 0; k < 4; ++k) { const v4u* hr = (const v4u*)(H + (size_t)row * D + 256 * k + 16 * i); const v4u h0 = hr[0], h1 = hr[1];
                hh[8 * k] = h0.x; hh[8 * k + 1] = h0.y; hh[8 * k + 2] = h0.z; hh[8 * k + 3] = h0.w; hh[8 * k + 4] = h1.x; hh[8 * k + 5] = h1.y; hh[8 * k + 6] = h1.z; hh[8 * k + 7] = h1.w; }
            const unsigned char* eub = eu + 16 * i;
#define PE_LD1(P, li, R) do { const unsigned k_ = (unsigned)__shfl((int)key[R], (lane & 48) | (li)); const unsigned e_ = k_ >> 7; \
            _Pragma("unroll") for (int k = 0; k < 4; ++k) P.u[k] = *(const v4u*)(eub + (size_t)e_ * D + 256 * k); P.su = esu[e_]; P.gs = grow[k_ & 127u] * esv[e_]; } while (0)
#define PE_DOT(P, d_) do { d_ = 0.f; \
            _Pragma("unroll") for (int k = 0; k < 4; ++k) _Pragma("unroll") for (int dd = 0; dd < 4; ++dd) { \
                const pe::bf16x2v ul_ = __builtin_amdgcn_cvt_scalef32_pk_bf16_fp8(P.u[k][dd], 1.0f, false), uh_ = __builtin_amdgcn_cvt_scalef32_pk_bf16_fp8(P.u[k][dd], 1.0f, true); \
                d_ = __builtin_amdgcn_fdot2_f32_bf16(ul_, __builtin_bit_cast(pe::bf16x2v, hh[8 * k + 2 * dd]), d_, false); \
                d_ = __builtin_amdgcn_fdot2_f32_bf16(uh_, __builtin_bit_cast(pe::bf16x2v, hh[8 * k + 2 * dd + 1]), d_, false); } } while (0)
            pe::URow X0, X1, X2, X3;
            const float* grow = egate + (size_t)row * 128;
#define PE_STEP(Xc, Xn, p0, U) do { PE_LD1(Xn, (((p0) + (U) + 3) >> 3) & 15, ((U) + 3) & 7);     \
            float d_; PE_DOT(Xc, d_); d_ = pe::group_sum16(d_); const float c_ = gelu_tanh(d_ * Xc.su) * Xc.gs; ck[U] = (i == ((p0) >> 3)) ? c_ : ck[U]; } while (0)
            PE_LD1(X0, 0, 0); PE_LD1(X1, 0, 1); PE_LD1(X2, 0, 2);
#pragma unroll 1
            for (int p0 = 0; p0 < 128; p0 += 8) {
                PE_STEP(X0, X3, p0, 0); PE_STEP(X1, X0, p0, 1); PE_STEP(X2, X1, p0, 2); PE_STEP(X3, X2, p0, 3);
                PE_STEP(X0, X3, p0, 4); PE_STEP(X1, X0, p0, 5); PE_STEP(X2, X1, p0, 6); PE_STEP(X3, X2, p0, 7);
            }
#undef PE_STEP
#undef PE_LD1
#undef PE_DOT
        }
        pe::f32x2 acc[32];
#pragma unroll
        for (int q = 0; q < 32; ++q) acc[q] = (pe::f32x2){0.f, 0.f};
        {
            const unsigned char* evb = ev + 16 * i;
#define PE_LD1(P, li, R) do { const unsigned e_ = (unsigned)__shfl((int)key[R], (lane & 48) | (li)) >> 7; \
            _Pragma("unroll") for (int k = 0; k < 4; ++k) P.v[k] = *(const v4u*)(evb + (size_t)e_ * D + 256 * k); } while (0)
#define PE_STEP(Xc, Xn, p0, U) do { PE_LD1(Xn, (((p0) + (U) + 3) >> 3) & 15, ((U) + 3) & 7);     \
            const float c_ = __shfl(ck[U], (lane & 48) | ((p0) >> 3)); const pe::f32x2 cc_ = (pe::f32x2){c_, c_}; \
            _Pragma("unroll") for (int k = 0; k < 4; ++k) _Pragma("unroll") for (int dd = 0; dd < 4; ++dd) { \
                acc[8 * k + 2 * dd] += cc_ * __builtin_amdgcn_cvt_pk_f32_fp8((int)Xc.v[k][dd], false); acc[8 * k + 2 * dd + 1] += cc_ * __builtin_amdgcn_cvt_pk_f32_fp8((int)Xc.v[k][dd], true); } } while (0)
            pe::VRow X0, X1, X2, X3;
            PE_LD1(X0, 0, 0); PE_LD1(X1, 0, 1); PE_LD1(X2, 0, 2);
#pragma unroll 1
            for (int p0 = 0; p0 < 128; p0 += 8) {
                PE_STEP(X0, X3, p0, 0); PE_STEP(X1, X0, p0, 1); PE_STEP(X2, X1, p0, 2); PE_STEP(X3, X2, p0, 3);
                PE_STEP(X0, X3, p0, 4); PE_STEP(X1, X0, p0, 5); PE_STEP(X2, X1, p0, 6); PE_STEP(X3, X2, p0, 7);
            }
#undef PE_STEP
#undef PE_LD1
        }
        const float* g2 = ada_l + (size_t)(row / SEQ) * 6 * D + 5 * D;
        float ss = 0.f;
#pragma unroll
        for (int k = 0; k < 4; ++k)
#pragma unroll
            for (int dd = 0; dd < 4; ++dd) { const int col = 256 * k + 16 * i + 4 * dd;
                const f32x4 xv = *(const f32x4*)(x1 + (size_t)row * D + col), gv = *(const f32x4*)(g2 + col);
                const f32x4 o = xv + gv * (f32x4){acc[8 * k + 2 * dd].x, acc[8 * k + 2 * dd].y, acc[8 * k + 2 * dd + 1].x, acc[8 * k + 2 * dd + 1].y};
                acc[8 * k + 2 * dd] = (pe::f32x2){o.x, o.y}; acc[8 * k + 2 * dd + 1] = (pe::f32x2){o.z, o.w};
                ss += (o.x * o.x + o.y * o.y) + (o.z * o.z + o.w * o.w); }
        const float rs = rsqrtf(pe::group_sum16(ss) * (1.0f / D) + EPS);
#pragma unroll
        for (int k = 0; k < 4; ++k)
#pragma unroll
            for (int dd = 0; dd < 4; ++dd) { const int col = 256 * k + 16 * i + 4 * dd;
                f32x4 o = (f32x4){acc[8 * k + 2 * dd].x, acc[8 * k + 2 * dd].y, acc[8 * k + 2 * dd + 1].x, acc[8 * k + 2 * dd + 1].y};
                if (fin) o = o * rs * *(const f32x4*)(final_g + col);
                *(f32x4*)(out + (size_t)row * D + col) = o;
                if (!fin) {
                    const float* na = nx_ada + (size_t)(row / SEQ) * 6 * D;
                    const f32x4 y = o * rs * *(const f32x4*)(nx_g + col) * (*(const f32x4*)(na + D + col) + 1.0f) + *(const f32x4*)(na + col);
                    v2u w; w.x = pk2(y.x, y.y); w.y = pk2(y.z, y.w); *(v2u*)(Hn + (size_t)row * D + col) = w; } }
    }
}
#endif
__global__ void __launch_bounds__(256) k_ksum(const bf16_t* proj, float* ksum) {
    const int gid = blockIdx.x * 256 + threadIdx.x;
    const int d = gid & 63, n = (gid >> 6) & 7, h = (gid >> 9) & 7, b = gid >> 12;
    float s = 0.f;
    for (int i = 0; i < MOBA; ++i) s += bf2f(proj[(size_t)(b * SEQ + n * MOBA + i) * INC + OKK + h * HD + d]);
    ksum[gid] = s;
}

__global__ void __launch_bounds__(64) k_attn_naive(const bf16_t* proj, const float* ksum, bf16_t* ya) {
    __shared__ float so[64];
    const int gid = blockIdx.x, h = gid & 7, row = gid >> 3, b = row / SEQ, t = row % SEQ, qb = t / MOBA, lane = threadIdx.x;
    const bf16_t* qp = proj + (size_t)row * INC + OQ + h * HD;
    float q[HD];
#pragma unroll
    for (int d = 0; d < HD; ++d) q[d] = bf2f(qp[d]);
    float g = -3.0e38f;
    if (lane < qb) { g = 0.f; const float* ks = ksum + (size_t)((b * 8 + h) * 8 + lane) * 64;
#pragma unroll
        for (int d = 0; d < HD; ++d) g += q[d] * ks[d]; }
    unsigned sel = 0;
    for (int r = 0; r < 3; ++r) {
        float best = 0.f; int bi = -1;
        for (int n = 0; n < 8; ++n) { const float gn = __shfl(g, n); if (n < qb && !((sel >> n) & 1u) && (bi < 0 || gn > best)) { best = gn; bi = n; } }
        if (bi >= 0) sel |= 1u << bi;
    }
    const float s2 = exp2f(-(float)(h + 1)) * LOG2E;
    float mrun = -1.0e30f, lrun = 0.f, o[HD];
#pragma unroll
    for (int d = 0; d < HD; ++d) o[d] = 0.f;
    for (int n = 0; n <= qb; ++n) {
        if (n < qb && !((sel >> n) & 1u)) continue;
        for (int i = lane; i < MOBA; i += 64) {
            const int j = n * MOBA + i;
            if (j > t) continue;
            const bf16_t* kr = proj + (size_t)(b * SEQ + j) * INC + OKK + h * HD;
            const bf16_t* vr = proj + (size_t)(b * SEQ + j) * INC + OV + h * HD;
            float s = 0.f;
#pragma unroll
            for (int d = 0; d < HD; ++d) s += q[d] * bf2f(kr[d]);
            s -= s2 * (float)(t - j);
            const float mn = fmaxf(mrun, s), f = exp2f(mrun - mn), p = exp2f(s - mn);
            lrun = lrun * f + p;
#pragma unroll
            for (int d = 0; d < HD; ++d) o[d] = o[d] * f + p * bf2f(vr[d]);
            mrun = mn;
        }
    }
    const float mall = wave_max(mrun), f = exp2f(mrun - mall);
    lrun = wave_sum(lrun * f);
#pragma unroll
    for (int d = 0; d < HD; ++d) { const float v = wave_sum(o[d] * f); if (lane == 0) so[d] = v; }
    __syncthreads();
    ya[(size_t)row * 512 + h * HD + lane] = f2bf(so[lane] / lrun);
}

__global__ void __launch_bounds__(64) k_score_topk(const bf16_t* qp, const float* sub_keys_l, float* tv, int* ti) {
    extern __shared__ float sm[];
    float* qs = sm;
    float* sc = sm + 64 * 129;
    const int t = threadIdx.x, row0 = blockIdx.x * 64, gp = blockIdx.y;
    for (int i = t; i < 64 * 128; i += 64) { const int r = i >> 7, d = i & 127; qs[r * 129 + d] = bf2f(qp[(size_t)(row0 + r) * QPW + gp * 128 + d]); }
    __syncthreads();
    const float* sk = sub_keys_l + (size_t)gp * NKEY * HALFK;
    for (int key = 0; key < NKEY; ++key) { float a = 0.f; for (int d = 0; d < HALFK; ++d) a += qs[t * 129 + d] * sk[key * HALFK + d]; sc[key * 64 + t] = a; }
    const size_t ob = ((size_t)(row0 + t) * 16 + gp) * 16;
    for (int r = 0; r < PTOP; ++r) {
        float best = sc[t]; int bi = 0;
        for (int key = 1; key < NKEY; ++key) { const float v = sc[key * 64 + t]; if (v > best) { best = v; bi = key; } }
        tv[ob + r] = best; ti[ob + r] = bi; sc[bi * 64 + t] = -3.0e38f;
    }
}
__global__ void __launch_bounds__(32) k_cand(const float* tv, const int* ti, int* eidx, float* egate) {
    __shared__ float cand[256 * 32];
    const int t = threadIdx.x, gid = blockIdx.x * 32 + t, hh = gid & 7, row = gid >> 3;
    const size_t b0 = ((size_t)row * 16 + hh * 2) * 16, b1 = b0 + 16;
    for (int i = 0; i < 16; ++i) for (int j = 0; j < 16; ++j) cand[(i * 16 + j) * 32 + t] = tv[b0 + i] + tv[b1 + j];
    float bv[PTOP]; int bp[PTOP];
#pragma unroll
    for (int r = 0; r < PTOP; ++r) {
        float best = cand[t]; int bi = 0;
        for (int p = 1; p < 256; ++p) { const float v = cand[p * 32 + t]; if (v > best) { best = v; bi = p; } }
        bv[r] = best; bp[r] = bi; cand[bi * 32 + t] = -3.0e38f;
    }
    float mx = bv[0], sum = 0.f;
#pragma unroll
    for (int r = 0; r < PTOP; ++r) { bv[r] = __expf(bv[r] - mx); sum += bv[r]; }
    const float inv = 1.0f / sum;
#pragma unroll
    for (int r = 0; r < PTOP; ++r) { eidx[(size_t)row * 128 + hh * 16 + r] = ti[b0 + (bp[r] >> 4)] * NKEY + ti[b1 + (bp[r] & 15)]; egate[(size_t)row * 128 + hh * 16 + r] = bv[r] * inv; }
}

template <bool FINAL>
__global__ void __launch_bounds__(256) k_peer_naive(const bf16_t* H, const float* x1, const int* eidx, const float* egate, const float* eu, const float* ev, const float* ada_l, const float* final_g, float* out) {
    const int row = blockIdx.x * 4 + (threadIdx.x >> 6), lane = threadIdx.x & 63, b = row / SEQ;
    float hv[16], acc[16];
#pragma unroll
    for (int i = 0; i < 4; ++i)
#pragma unroll
        for (int j = 0; j < 4; ++j) { hv[4 * i + j] = bf2f(H[(size_t)row * D + i * 256 + lane * 4 + j]); acc[4 * i + j] = 0.f; }
    for (int e = 0; e < 128; ++e) {
        const int idx = eidx[(size_t)row * 128 + e]; const float g = egate[(size_t)row * 128 + e];
        const float* ur = eu + (size_t)idx * D; const float* vr = ev + (size_t)idx * D;
        float dsum = 0.f;
#pragma unroll
        for (int i = 0; i < 4; ++i) { const float4 u = *(const float4*)(ur + i * 256 + lane * 4); dsum += hv[4 * i] * u.x + hv[4 * i + 1] * u.y + hv[4 * i + 2] * u.z + hv[4 * i + 3] * u.w; }
        dsum = wave_sum(dsum);
        const float cc = g * gelu_tanh(dsum);
#pragma unroll
        for (int i = 0; i < 4; ++i) { const float4 v = *(const float4*)(vr + i * 256 + lane * 4); acc[4 * i] += cc * v.x; acc[4 * i + 1] += cc * v.y; acc[4 * i + 2] += cc * v.z; acc[4 * i + 3] += cc * v.w; }
    }
    const float* g2 = ada_l + (size_t)b * 6 * D + 5 * D;
    float o[16]; float ss = 0.f;
#pragma unroll
    for (int i = 0; i < 4; ++i)
#pragma unroll
        for (int j = 0; j < 4; ++j) { const int col = i * 256 + lane * 4 + j; o[4 * i + j] = x1[(size_t)row * D + col] + g2[col] * acc[4 * i + j]; ss += o[4 * i + j] * o[4 * i + j]; }
    if (FINAL) {
        ss = wave_sum(ss);
        const float r = rsqrtf(ss * (1.0f / D) + EPS);
#pragma unroll
        for (int i = 0; i < 4; ++i)
#pragma unroll
            for (int j = 0; j < 4; ++j) { const int col = i * 256 + lane * 4 + j; o[4 * i + j] = o[4 * i + j] * r * final_g[col]; }
    }
#pragma unroll
    for (int i = 0; i < 4; ++i) *(float4*)(out + (size_t)row * D + i * 256 + lane * 4) = make_float4(o[4 * i], o[4 * i + 1], o[4 * i + 2], o[4 * i + 3]);
}


constexpr int N_STEPS = 1 + 9 * DEPTH;
struct Args { const float* in[16]; float* out; unsigned char* ws; int s_lo, s_hi, li, pad; };

__global__ void __launch_bounds__(NWAVES * 64, 2) mega(Args args) {
    extern __shared__ __attribute__((aligned(16))) unsigned char lds_raw[];
    Frame F;
    F.lds = (LAS unsigned char*)lds_raw;
    F.tid = threadIdx.x; F.lane = F.tid & 63; F.wave = __builtin_amdgcn_readfirstlane(F.tid >> 6);
    F.G = gridDim.x; { const int bx = blockIdx.x; F.vcu = (F.G % 8 == 0) ? (bx % 8) * (F.G / 8) + bx / 8 : bx; }
    gu32* ctl = (gu32*)(args.ws + WS_CTL);
    volatile LAS unsigned* MISC = (volatile LAS unsigned*)(F.lds + MISC_OFF);
    for (int u = F.tid; u < (LDS_BYTES - LDSCTL_OFF) / 4; u += NWAVES * 64) ((LAS unsigned*)(F.lds + LDSCTL_OFF))[u] = 0u;
    __syncthreads();
    const bool multi = (args.s_hi - args.s_lo) > 1;
    XcdBarrier bar; bar.bar = (unsigned*)(ctl + CW_BAR) + args.li * XCD_BAR_WORDS; bar.x = 0; bar.st = MISC + 8;
    if (multi) bar = xcd_barrier_post((unsigned*)(ctl + CW_BAR) + args.li * XCD_BAR_WORDS, MISC + 8);

    const int vcu0 = F.vcu;
#ifdef PROBE_MASK
    for (int s2_ = 2 * args.s_lo; s2_ < 2 * args.s_hi; ++s2_) { const int s = s2_ >> 1;
        { const int ptype_ = (s == 0) ? 0 : 1 + (s - 1) % 9; if ((s2_ & 1) && !((PROBE_MASK >> ptype_) & 1)) continue; }
#else
    for (int s = args.s_lo; s < args.s_hi; ++s) {
#endif
        F.tid = laundered_tid(); F.lane = F.tid & 63; F.wave = __builtin_amdgcn_readfirstlane(F.tid >> 6);
        { int v_ = vcu0; asm volatile("" : "+s"(v_)); F.vcu = v_; }
        size_t zoff_ = 0; asm volatile("" : "+s"(zoff_));
        unsigned char* ws = args.ws + zoff_;
        float* ada = (float*)(ws + WS_ADA);
        bf16_t* H = (bf16_t*)(ws + WS_H); bf16_t* proj = (bf16_t*)(ws + WS_PROJ); bf16_t* qp = (bf16_t*)(ws + WS_QP);
        bf16_t* ya = (bf16_t*)(ws + WS_YA); bf16_t* yc = (bf16_t*)(ws + WS_YC); bf16_t* mrg = (bf16_t*)(ws + WS_MRG);
        float* x1 = (float*)(ws + WS_X1); int* eidx = (int*)(ws + WS_EIDX); float* egate = (float*)(ws + WS_EGATE);
        if (s == 0) {
            P0Args a{args.in[1], args.in[4], args.in[5], args.in[6], args.in[8], args.in[9], args.in[10], args.in[11], args.in[12], args.in[13], args.in[14], ws};
            p0_prologue(F, a);
        } else {
            const int l = (s - 1) / 9, ph = (s - 1) % 9;
            if (ph == 0 && l > 0) continue;
            const float* xl = (l == 0) ? args.in[0] : (const float*)args.out;
            const float* ada_l = ada + (size_t)l * BATCH * 6 * D;
            if (ph == 0) {
                norm_phase(F, xl, args.in[2] + l * D, ada_l, 0, D, H);
            } else if (ph == 1) {
                pg8::Gemm g{H, (const bf16_t*)(ws + WS_WIN) + (size_t)l * INC * D, M, INC, D}; pg8::StaticOrder S; S.init(M, INC, F.G, (int)blockIdx.x);
                pg8::EpiBf16S E{proj, INC, 512, C2};
                pg8::gemm_phase<pg8::EpiBf16S, pg8::StaticOrder, true, true>(F.lds + RING_OFF, g, S, E);
            } else if (ph == 2) {
#if !USE_NAIVE_AT
                attn_phase_all(F, proj, ya);
#endif
                conv_phase(F, proj, args.in[7] + l * 3 * 512, yc);
            } else if (ph == 3) {
                { pg8::Gemm g{ya, (const bf16_t*)(ws + WS_WAP) + (size_t)l * D * 512, M, D, 512}; pg8::StaticOrder S; S.init(M, D, F.G, (int)blockIdx.x);
                  pg8::EpiGate<true> E{proj + OGA, mrg};
                  pg8::gemm_phase<pg8::EpiGate<true>, pg8::StaticOrder, true, true>(F.lds + RING_OFF, g, S, E); }
                { pg8::Gemm g{yc, (const bf16_t*)(ws + WS_WCP) + (size_t)l * D * 512, M, D, 512}; pg8::StaticOrder S; S.init(M, D, F.G, (int)blockIdx.x);
                  pg8::EpiGate<false> E{proj + OGC, mrg};
                  pg8::gemm_phase<pg8::EpiGate<false>, pg8::StaticOrder, true, true>(F.lds + RING_OFF, g, S, E); }
            } else if (ph == 4) {
                pg8::Gemm g{mrg, (const bf16_t*)(ws + WS_WOUT) + (size_t)l * D * D, M, D, D}; pg8::StaticOrder S; S.init(M, D, F.G, (int)blockIdx.x);
                pg8::EpiResid E{xl, ada_l, x1};
                pg8::gemm_phase<pg8::EpiResid, pg8::StaticOrder, true, true>(F.lds + RING_OFF, g, S, E);
            } else if (ph == 5) {
                norm_phase(F, x1, args.in[3] + l * D, ada_l, 3 * D, 4 * D, H);
            } else if (ph == 6) {
                pg8::Gemm g{H, (const bf16_t*)(ws + WS_WQ) + (size_t)l * QPW * D, M, QPW, D}; pg8::StaticOrder S; S.init(M, QPW, F.G, (int)blockIdx.x);
                pg8::EpiBf16S E{qp, QPW, 0, 1.0f};
                pg8::gemm_phase<pg8::EpiBf16S, pg8::StaticOrder, true, true>(F.lds + RING_OFF, g, S, E);
            } else if (ph == 7) {
#if !USE_NAIVE_TK
                topk_phase(F, qp, (const bf16_t*)(ws + WS_SK) + (size_t)l * 16 * NKEY * HALFK, eidx, egate);
#endif
            } else {
#if !USE_NAIVE_PE
                peer_phase(F, l, H, x1, eidx, egate, ws + WS_EU + (size_t)l * NEXP * D, ws + WS_EV + (size_t)l * NEXP * D, (const float*)(ws + WS_ESU) + l * NEXP, (const float*)(ws + WS_ESV) + l * NEXP, ada_l, args.in[15], args.out, args.in[2] + (l + 1) * D, ada + (size_t)(l + 1) * BATCH * 6 * D, H);
#endif
            }
        }
#ifdef PROBE_MASK
        if (s2_ + 1 < 2 * args.s_hi) xcd_barrier(bar);
#else
        if (s + 1 < args.s_hi) xcd_barrier(bar);
#endif
    }
}

extern "C" void kernel_launch(void* const* d_in, const int* in_sizes, int n_in, void* d_out, int out_size, void* d_ws, size_t ws_size, hipStream_t stream) {
    static int grid = 0;
    if (grid == 0) {
        if (n_in != 16 || out_size != M * D || ws_size < WS_END) { fprintf(stderr, "kernel_launch: unexpected shapes (n_in %d out %d ws %zu)\n", n_in, out_size, ws_size); grid = -1; return; }
        int dev = 0, cus = 0, per_cu = 0;
        if (hipGetDevice(&dev) != hipSuccess || hipDeviceGetAttribute(&cus, hipDeviceAttributeMultiprocessorCount, dev) != hipSuccess) { grid = -1; return; }
        if (hipFuncSetAttribute((const void*)mega, hipFuncAttributeMaxDynamicSharedMemorySize, LDS_BYTES) != hipSuccess) { fprintf(stderr, "kernel_launch: hipFuncSetAttribute failed\n"); grid = -1; return; }
        if (hipOccupancyMaxActiveBlocksPerMultiprocessor(&per_cu, (const void*)mega, NWAVES * 64, LDS_BYTES) != hipSuccess || per_cu < 1) { fprintf(stderr, "kernel_launch: occupancy query says %d blocks/CU\n", per_cu); per_cu = 1; }
        (void)hipGetLastError();
        grid = cus * 1;
#if USE_NAIVE_TK
        (void)hipFuncSetAttribute((const void*)k_score_topk, hipFuncAttributeMaxDynamicSharedMemorySize, (64 * 129 + 128 * 64) * 4);
#endif
        fprintf(stderr, "kernel_launch: grid %d (cus %d, occupancy %d/CU)\n", grid, cus, per_cu);
    }
    if (grid < 0) return;
    (void)hipMemsetAsync((char*)d_ws + WS_CTL, 0, CTL_ZERO_BYTES, stream);
    Args a{};
    for (int i = 0; i < 16; ++i) a.in[i] = (const float*)d_in[i];
    a.out = (float*)d_out; a.ws = (unsigned char*)d_ws;
#if MEGA_ONE
    a.s_lo = 0; a.s_hi = N_STEPS; a.li = 0;
    void* kargs[] = {&a};
    hipError_t e = hipLaunchCooperativeKernel((const void*)mega, dim3(grid), dim3(NWAVES * 64), kargs, LDS_BYTES, stream);
    if (e != hipSuccess) fprintf(stderr, "kernel_launch: cooperative launch failed: %s (grid %d)\n", hipGetErrorString(e), grid);
#else
    unsigned char* ws = (unsigned char*)d_ws; float* out = (float*)d_out;
    float* ada = (float*)(ws + WS_ADA); float* ksum = (float*)(ws + WS_KSUM);
    bf16_t* H = (bf16_t*)(ws + WS_H); bf16_t* proj = (bf16_t*)(ws + WS_PROJ); bf16_t* qp = (bf16_t*)(ws + WS_QP);
    float* tv = (float*)(ws + WS_TV); int* ti = (int*)(ws + WS_TI);
    bf16_t* ya = (bf16_t*)(ws + WS_YA);
    float* x1 = (float*)(ws + WS_X1); int* eidx = (int*)(ws + WS_EIDX); float* egate = (float*)(ws + WS_EGATE);
    (void)ada; (void)ksum; (void)H; (void)proj; (void)qp; (void)tv; (void)ti; (void)ya; (void)x1; (void)eidx; (void)egate; (void)out;
    for (int s = 0; s < N_STEPS; ++s) {
        const int l = s ? (s - 1) / 9 : 0, ph = s ? (s - 1) % 9 : -1;
        const float* ada_l = ada + (size_t)l * BATCH * 6 * D; (void)ada_l;
#if USE_NAIVE_AT
        if (ph == 2) { k_ksum<<<BATCH * 8 * 8 * 64 / 256, 256, 0, stream>>>(proj, ksum); k_attn_naive<<<M * NH, 64, 0, stream>>>(proj, ksum, ya); }
#endif
#if USE_NAIVE_TK
        if (ph == 7) { k_score_topk<<<dim3(M / 64, 16), 64, (64 * 129 + 128 * 64) * 4, stream>>>(qp, (const float*)d_in[12] + (size_t)l * PH * 2 * NKEY * HALFK, tv, ti); k_cand<<<M * PH / 32, 32, 0, stream>>>(tv, ti, eidx, egate); continue; }
#endif
#if USE_NAIVE_PE
        if (ph == 8) {
            const float* eu = (const float*)d_in[13] + (size_t)l * NEXP * D; const float* ev = (const float*)d_in[14] + (size_t)l * NEXP * D;
            if (l == DEPTH - 1) k_peer_naive<true><<<M / 4, 256, 0, stream>>>(H, x1, eidx, egate, eu, ev, ada_l, (const float*)d_in[15], out);
            else k_peer_naive<false><<<M / 4, 256, 0, stream>>>(H, x1, eidx, egate, eu, ev, ada_l, (const float*)d_in[15], out);
            continue; }
#endif
        a.s_lo = s; a.s_hi = s + 1; a.li = 0;
        hipLaunchKernelGGL(mega, dim3(grid), dim3(NWAVES * 64), LDS_BYTES, stream, a);
    }
#endif
}
```

```cpp
#include <hip/hip_runtime.h>
#include <cstdint>
#include <cstdio>

typedef unsigned short bf16_t;
#define LAS __attribute__((address_space(3)))
#define GAS __attribute__((address_space(1)))

constexpr int D = 1024, BATCH = 8, SEQ = 2048, M = BATCH * SEQ, DEPTH = 2;
constexpr int NH = 8, HD = 64, MOBA = 256, NBLK = SEQ / MOBA;
constexpr int INC = 5120;
constexpr int OQ = 0, OKK = 512, OV = 1024, OBG = 1536, OCG = 2048, OHC = 2560, OGA = 3072, OGC = 4096;
constexpr int PH = 8, NKEY = 128, NEXP = NKEY * NKEY, DKEY = 256, HALFK = 128, PTOP = 16;
constexpr int QPW = PH * DKEY;
constexpr float EPS = 1e-6f;
constexpr float LOG2E = 1.4426950408889634f;
constexpr float C2 = 0.125f * LOG2E;

constexpr size_t MiB = 1u << 20;
constexpr size_t WS_CTL = 0, CTL_ZERO_BYTES = 2 * MiB;
constexpr size_t WS_ADA = 1 * MiB;
constexpr size_t WS_KSUM = 2 * MiB;
constexpr size_t WS_WIN = 3 * MiB;
constexpr size_t WS_WAP = 23 * MiB;
constexpr size_t WS_WCP = 25 * MiB;
constexpr size_t WS_WOUT = 27 * MiB;
constexpr size_t WS_WQ = 31 * MiB;
constexpr size_t WS_SK = 39 * MiB;
constexpr size_t WS_H = 40 * MiB;
constexpr size_t WS_PROJ = 72 * MiB;
constexpr size_t WS_QP = 72 * MiB;
constexpr size_t WS_TV = 136 * MiB;
constexpr size_t WS_TI = 152 * MiB;
constexpr size_t WS_YA = 232 * MiB;
constexpr size_t WS_YC = 248 * MiB;
constexpr size_t WS_MRG = 264 * MiB;
constexpr size_t WS_X1 = 296 * MiB;
constexpr size_t WS_EIDX = 360 * MiB;
constexpr size_t WS_EGATE = 368 * MiB;
constexpr size_t WS_EU = 376 * MiB;
constexpr size_t WS_EV = 408 * MiB;
constexpr size_t WS_ESU = 440 * MiB;
constexpr size_t WS_ESV = 441 * MiB;
constexpr size_t WS_END = 442 * MiB;

__device__ __forceinline__ float bf2f(bf16_t v) { return __uint_as_float((unsigned)v << 16); }
__device__ __forceinline__ unsigned f2bf_u(float f) { unsigned u = __float_as_uint(f); return (u + 0x7fffu + ((u >> 16) & 1u)) >> 16; }
__device__ __forceinline__ bf16_t f2bf(float f) { return (bf16_t)f2bf_u(f); }
__device__ __forceinline__ unsigned pk2(float lo, float hi) { return f2bf_u(lo) | (f2bf_u(hi) << 16); }
__device__ __forceinline__ float bflo(unsigned w) { return __uint_as_float(w << 16); }
__device__ __forceinline__ float bfhi(unsigned w) { return __uint_as_float(w & 0xffff0000u); }
__device__ __forceinline__ float sigmoidf_(float x) { return __builtin_amdgcn_rcpf(1.0f + __expf(-x)); }
__device__ __forceinline__ float gelu_tanh(float x) { const float u = 0.7978845608028654f * (x + 0.044715f * x * x * x); const float e = __expf(2.0f * u); return x - x * __builtin_amdgcn_rcpf(e + 1.0f); }
__device__ __forceinline__ float wave_sum(float v) {
#pragma unroll
    for (int o = 1; o < 64; o <<= 1) v += __shfl_xor(v, o);
    return v;
}
__device__ __forceinline__ float wave_max(float v) {
#pragma unroll
    for (int o = 1; o < 64; o <<= 1) v = fmaxf(v, __shfl_xor(v, o));
    return v;
}
__device__ __forceinline__ int laundered_tid() { int t = threadIdx.x; asm volatile("" : "+v"(t)); return t; }
#define USE_NAIVE_AT 0
#define USE_NAIVE_TK 0
#define USE_NAIVE_PE 0
#define MEGA_ONE 1

namespace pg8 {
#define PG8_LAS __attribute__((address_space(3)))
typedef unsigned short bf16_t;
typedef short bf16x8 __attribute__((ext_vector_type(8)));
typedef float f32x4 __attribute__((ext_vector_type(4)));
typedef unsigned u32x4 __attribute__((ext_vector_type(4)));
constexpr int BM = 256, BK = 64, HALF = 128, HTB = HALF * BK * 2  , STAGE_BYTES = 8 * HTB, NXCD = 8, WGM = 8;

__host__ __device__ __forceinline__ int lds_byte(int r, int c) { const int st = (r >> 4) * 2 + (c >> 5), rr = r & 15, cc = c & 31, ob = rr * 64 + cc * 2; return st * 1024 + (ob ^ (((ob >> 9) & 1) << 5)); }
__host__ __device__ __forceinline__ void stage_rc(int b, int& R, int& C) { const int st = b / 1024, sb = b % 1024, swz = sb ^ (((sb >> 9) & 1) << 5); R = (st >> 1) * 16 + swz / 64; C = (st & 1) * 32 + (swz % 64) / 2; }
__host__ __device__ __forceinline__ int perm32(int rho) { const int n = rho >> 4, i = rho & 15; return 8 * (i >> 2) + 4 * n + (i & 3); }

struct Unit { int pm, pn; };
struct Gemm { const bf16_t* A; const bf16_t* Bt; int M, N, K; };

struct StaticOrder {
    int nM, nN, nwg, G, c;
    __host__ __device__ void init(int M, int N, int G_, int c_) { nM = M / BM; nN = N / BM; nwg = nM * nN; G = G_; c = c_; }
    __host__ __device__ bool next(int i, Unit& u) const {
        const long L = (long)i * G + c; if (L >= nwg) return false;
        int wgid = (int)L; { const int q = nwg / NXCD, r = nwg % NXCD, xcd = wgid % NXCD, off = wgid / NXCD; wgid = (xcd < r ? xcd * (q + 1) : r * (q + 1) + (xcd - r) * q) + off; }
        const int nig = WGM * nN, gid = wgid / nig, fm = gid * WGM, gsz = (nM - fm) < WGM ? (nM - fm) : WGM;
        u.pm = fm + ((wgid % nig) % gsz); u.pn = (wgid % nig) / gsz; return true;
    }
    __device__ __forceinline__ void a_ready(const Unit&) const {}
    __device__ __forceinline__ void done(const Unit&) const {}
};


__device__ __forceinline__ unsigned cvt_pk_bf16(float lo, float hi) { unsigned r; asm volatile("v_cvt_pk_bf16_f32 %0, %1, %2" : "=v"(r) : "v"(lo), "v"(hi)); return r; }

struct EpiBf16S {
    static constexpr bool PERM = true, AFTER_DRAIN = false;
    bf16_t* O; int ldc; int scale_cols; float scale0;
    __device__ __forceinline__ void operator()(const f32x4 (&acc)[2][2][4][2], const Unit& u, int wr, int wc, int fr, int fq) const {
        const int row0 = u.pm * BM + wr * 64 + fr, col0 = u.pn * BM + wc * 32 + 8 * fq;
        const float sc = (u.pn * BM < scale_cols) ? scale0 : 1.0f;
#pragma unroll
        for (int ai = 0; ai < 2; ++ai)
#pragma unroll
            for (int m = 0; m < 4; ++m) { bf16_t* rowp = O + (size_t)(row0 + ai * HALF + m * 16) * ldc + col0;
#pragma unroll
                for (int bj = 0; bj < 2; ++bj) { const f32x4 v0 = acc[ai][bj][m][0] * sc, v1 = acc[ai][bj][m][1] * sc;
                    u32x4 w; w.x = cvt_pk_bf16(v0[0], v0[1]); w.y = cvt_pk_bf16(v0[2], v0[3]); w.z = cvt_pk_bf16(v1[0], v1[1]); w.w = cvt_pk_bf16(v1[2], v1[3]);
                    *(u32x4*)(rowp + bj * HALF) = w; } }
    }
};
template <bool FIRST> struct EpiGate {
    static constexpr bool PERM = true, AFTER_DRAIN = false;
    const bf16_t* gate; bf16_t* mrg;
    __device__ __forceinline__ void operator()(const f32x4 (&acc)[2][2][4][2], const Unit& u, int wr, int wc, int fr, int fq) const {
        const int row0 = u.pm * BM + wr * 64 + fr, col0 = u.pn * BM + wc * 32 + 8 * fq;
#pragma unroll
        for (int ai = 0; ai < 2; ++ai)
#pragma unroll
            for (int m = 0; m < 4; ++m) { const size_t row = (size_t)(row0 + ai * HALF + m * 16);
#pragma unroll
                for (int bj = 0; bj < 2; ++bj) {
                    const u32x4 gw = *(const u32x4*)(gate + row * INC + col0 + bj * HALF);
                    bf16_t* op = mrg + row * D + col0 + bj * HALF;
                    const f32x4 a0 = acc[ai][bj][m][0], a1 = acc[ai][bj][m][1];
                    float r[8];
                    r[0] = sigmoidf_(bflo(gw.x)) * a0[0]; r[1] = sigmoidf_(bfhi(gw.x)) * a0[1]; r[2] = sigmoidf_(bflo(gw.y)) * a0[2]; r[3] = sigmoidf_(bfhi(gw.y)) * a0[3];
                    r[4] = sigmoidf_(bflo(gw.z)) * a1[0]; r[5] = sigmoidf_(bfhi(gw.z)) * a1[1]; r[6] = sigmoidf_(bflo(gw.w)) * a1[2]; r[7] = sigmoidf_(bfhi(gw.w)) * a1[3];
                    if (!FIRST) { const u32x4 pw = *(const u32x4*)op;
                        r[0] += bflo(pw.x); r[1] += bfhi(pw.x); r[2] += bflo(pw.y); r[3] += bfhi(pw.y); r[4] += bflo(pw.z); r[5] += bfhi(pw.z); r[6] += bflo(pw.w); r[7] += bfhi(pw.w); }
                    u32x4 w; w.x = cvt_pk_bf16(r[0], r[1]); w.y = cvt_pk_bf16(r[2], r[3]); w.z = cvt_pk_bf16(r[4], r[5]); w.w = cvt_pk_bf16(r[6], r[7]);
                    *(u32x4*)op = w; } }
    }
};
struct EpiResid {
    static constexpr bool PERM = false, AFTER_DRAIN = false;
    const float* xin; const float* ada_l; float* x1;
    __device__ __forceinline__ void operator()(const f32x4 (&acc)[2][2][4][2], const Unit& u, int wr, int wc, int fr, int fq) const {
        const int row0 = u.pm * BM + wr * 64 + fr, col0 = u.pn * BM + wc * 32 + 4 * fq;
        const float* g1 = ada_l + (size_t)((u.pm * BM) / SEQ) * 6 * D + 2 * D + col0;
        f32x4 gv[2][2];
#pragma unroll
        for (int bj = 0; bj < 2; ++bj)
#pragma unroll
            for (int n = 0; n < 2; ++n) gv[bj][n] = *(const f32x4*)(g1 + bj * HALF + n * 16);
#pragma unroll
        for (int ai = 0; ai < 2; ++ai)
#pragma unroll
            for (int m = 0; m < 4; ++m) { const size_t off = (size_t)(row0 + ai * HALF + m * 16) * D + col0;
#pragma unroll
                for (int bj = 0; bj < 2; ++bj)
#pragma unroll
                    for (int n = 0; n < 2; ++n) { const f32x4 xv = *(const f32x4*)(xin + off + bj * HALF + n * 16);
                        *(f32x4*)(x1 + off + bj * HALF + n * 16) = xv + gv[bj][n] * acc[ai][bj][m][n]; } }
    }
};
template <class Epi, class Sched, bool ALIGN_EPI = false, bool SP2 = false>
__device__ __forceinline__ void gemm_phase(PG8_LAS unsigned char* lds, const Gemm g, const Sched& S, const Epi& E) {
    const int tid = laundered_tid(), wid = __builtin_amdgcn_readfirstlane(tid >> 6), lane = tid & 63, wr = wid >> 2, wc = wid & 3, fr = lane & 15, fq = lane >> 4;
    const int K = g.K, nt = K / BK;
    unsigned voffA[2], voffB[2];
#pragma unroll
    for (int i = 0; i < 2; ++i) { int R, C; stage_rc(tid * 16 + i * 8192, R, C); const int Rb = Epi::PERM ? ((R & ~31) + perm32(R & 31)) : R;
        voffA[i] = (unsigned)(R * K + C) * 2u; voffB[i] = (unsigned)(Rb * K + C) * 2u; }
    const size_t kstep = (size_t)(BK * 2);
    const size_t hstep = (size_t)HALF * K * 2;
    const size_t tstep = 2 * hstep;
    const unsigned ldsw = (unsigned)wid * 1024u;
    const int aoff = lds_byte(wr * 64 + fr, fq * 8), boff = lds_byte(wc * 32 + fr, fq * 8);
#define PG8_SA(b, h) (((b) * 2 + (h)) * HTB)
#define PG8_SB(b, h) ((4 + (b) * 2 + (h)) * HTB)
#define PG8_STAGE(bufoff, gbase, voff) do { _Pragma("unroll") for (int _i = 0; _i < 2; ++_i) \
        __builtin_amdgcn_global_load_lds((const unsigned*)((const char*)(gbase) + (voff)[_i]), (PG8_LAS unsigned*)(lds + (bufoff) + ldsw + _i * 8192), 16, 0, 0); } while (0)
#define PG8_LDA(dst, b, h) do { _Pragma("unroll") for (int m = 0; m < 4; ++m) _Pragma("unroll") for (int k = 0; k < 2; ++k) dst[m][k] = *(const PG8_LAS bf16x8*)(lds + PG8_SA(b, h) + aoff + m * 2048 + k * 1024); } while (0)
#define PG8_LDB(dst, b, h) do { _Pragma("unroll") for (int n = 0; n < 2; ++n) _Pragma("unroll") for (int k = 0; k < 2; ++k) dst[n][k] = *(const PG8_LAS bf16x8*)(lds + PG8_SB(b, h) + boff + n * 2048 + k * 1024); } while (0)
#define PG8_MMA(ai, bj, At, Bt) do { __builtin_amdgcn_s_setprio(1); _Pragma("unroll") for (int m = 0; m < 4; ++m) _Pragma("unroll") for (int n = 0; n < 2; ++n) _Pragma("unroll") for (int k = 0; k < 2; ++k) \
        acc[ai][bj][m][n] = __builtin_amdgcn_mfma_f32_16x16x32_bf16(Bt[n][k], At[m][k], acc[ai][bj][m][n], 0, 0, 0); __builtin_amdgcn_s_setprio(0); } while (0)
#define PG8_WAIT_V(n) asm volatile("s_waitcnt vmcnt(" #n ")" ::: "memory")
#define PG8_WAIT_L(n) asm volatile("s_waitcnt lgkmcnt(" #n ")" ::: "memory")
#define PG8_BAR __builtin_amdgcn_s_barrier()
#define PG8_SCHED __builtin_amdgcn_sched_barrier(0)
    Unit cur, nxt; int ui = 0;
    if (!S.next(0, cur)) return;
    f32x4 acc[2][2][4][2];
#pragma unroll
    for (int a = 0; a < 2; ++a)
#pragma unroll
        for (int b = 0; b < 2; ++b)
#pragma unroll
            for (int m = 0; m < 4; ++m)
#pragma unroll
                for (int n = 0; n < 2; ++n) acc[a][b][m][n] = (f32x4){0.f, 0.f, 0.f, 0.f};
    bf16x8 At[4][2], B0[2][2], B1[2][2];
    const char* cA = (const char*)g.A + (size_t)cur.pm * tstep; const char* cB = (const char*)g.Bt + (size_t)cur.pn * tstep;
    S.a_ready(cur);
    if constexpr (SP2) {
        PG8_STAGE(PG8_SB(0, 0), cB, voffB); PG8_STAGE(PG8_SB(0, 1), cB + hstep, voffB); PG8_STAGE(PG8_SA(0, 0), cA, voffA); PG8_STAGE(PG8_SA(0, 1), cA + hstep, voffA);
        if (wr == 1) PG8_BAR;
        PG8_WAIT_V(2); PG8_BAR;
        PG8_STAGE(PG8_SB(1, 0), cB + kstep, voffB); PG8_STAGE(PG8_SA(1, 0), cA + kstep, voffA); PG8_STAGE(PG8_SB(1, 1), cB + hstep + kstep, voffB);
        PG8_WAIT_V(6); PG8_BAR;
    } else {
        PG8_STAGE(PG8_SB(0, 0), cB, voffB); PG8_STAGE(PG8_SA(0, 0), cA, voffA); PG8_STAGE(PG8_SB(0, 1), cB + hstep, voffB); PG8_STAGE(PG8_SA(0, 1), cA + hstep, voffA);
        if (wr == 1) PG8_BAR;
        PG8_WAIT_V(4); PG8_BAR;
        PG8_STAGE(PG8_SB(1, 0), cB + kstep, voffB); PG8_STAGE(PG8_SA(1, 0), cA + kstep, voffA); PG8_STAGE(PG8_SB(1, 1), cB + hstep + kstep, voffB);
        PG8_WAIT_V(6); PG8_BAR;
    }
    for (;;) {
        const bool has_next = S.next(ui + 1, nxt);
        const char* nA = has_next ? (const char*)g.A + (size_t)nxt.pm * tstep : cA; const char* nB = has_next ? (const char*)g.Bt + (size_t)nxt.pn * tstep : cB;
        for (int t = 0; t < nt; t += 2) {
            const bool last = (t == nt - 2);
            const char* a1 = cA + (size_t)(t + 1) * kstep;
            const char* a2 = last ? nA : cA + (size_t)(t + 2) * kstep; const char* b2 = last ? nB : cB + (size_t)(t + 2) * kstep;
            const char* a3 = a2 + kstep; const char* b3 = b2 + kstep;
            if (last && has_next) S.a_ready(nxt);
            if constexpr (SP2) {
            PG8_LDB(B0, 0, 0); PG8_LDB(B1, 0, 1); PG8_SCHED; PG8_LDA(At, 0, 0); PG8_STAGE(PG8_SA(1, 1), a1 + hstep, voffA);
            PG8_WAIT_V(8); PG8_WAIT_L(0); PG8_BAR; PG8_MMA(0, 0, At, B0); PG8_MMA(0, 1, At, B1); PG8_BAR; PG8_SCHED;
            PG8_LDA(At, 0, 1); PG8_STAGE(PG8_SB(0, 0), b2, voffB); PG8_STAGE(PG8_SB(0, 1), b2 + hstep, voffB); PG8_STAGE(PG8_SA(0, 0), a2, voffA);
            PG8_WAIT_V(8); PG8_WAIT_L(0); PG8_BAR; PG8_MMA(1, 0, At, B0); PG8_MMA(1, 1, At, B1); PG8_BAR; PG8_SCHED;
            PG8_LDB(B0, 1, 0); PG8_LDB(B1, 1, 1); PG8_SCHED; PG8_LDA(At, 1, 0); PG8_STAGE(PG8_SA(0, 1), a2 + hstep, voffA);
            PG8_WAIT_V(8); PG8_WAIT_L(0); PG8_BAR; PG8_MMA(0, 0, At, B0); PG8_MMA(0, 1, At, B1); PG8_BAR; PG8_SCHED;
            PG8_LDA(At, 1, 1); PG8_STAGE(PG8_SB(1, 0), b3, voffB); PG8_STAGE(PG8_SB(1, 1), b3 + hstep, voffB); PG8_STAGE(PG8_SA(1, 0), a3, voffA);
            PG8_WAIT_V(8); PG8_WAIT_L(0); PG8_BAR; PG8_MMA(1, 0, At, B0); PG8_MMA(1, 1, At, B1); PG8_BAR; PG8_SCHED;
            } else {
            PG8_LDB(B0, 0, 0); PG8_SCHED; PG8_LDA(At, 0, 0); PG8_STAGE(PG8_SA(1, 1), a1 + hstep, voffA);
            PG8_WAIT_L(8); PG8_BAR; PG8_WAIT_L(0); PG8_MMA(0, 0, At, B0); PG8_BAR; PG8_SCHED;
            PG8_LDB(B1, 0, 1); PG8_STAGE(PG8_SB(0, 0), b2, voffB);
            PG8_BAR; PG8_WAIT_L(0); PG8_MMA(0, 1, At, B1); PG8_BAR;
            PG8_LDA(At, 0, 1); PG8_STAGE(PG8_SA(0, 0), a2, voffA);
            PG8_BAR; PG8_WAIT_L(0); PG8_MMA(1, 0, At, B0); PG8_BAR; PG8_SCHED;
            PG8_STAGE(PG8_SB(0, 1), b2 + hstep, voffB);
            PG8_WAIT_V(6); PG8_BAR; PG8_MMA(1, 1, At, B1); PG8_BAR;
            PG8_LDB(B0, 1, 0); PG8_SCHED; PG8_LDA(At, 1, 0); PG8_STAGE(PG8_SA(0, 1), a2 + hstep, voffA);
            PG8_WAIT_L(8); PG8_BAR; PG8_WAIT_L(0); PG8_MMA(0, 0, At, B0); PG8_BAR; PG8_SCHED;
            PG8_LDB(B1, 1, 1); PG8_STAGE(PG8_SB(1, 0), b3, voffB);
            PG8_BAR; PG8_WAIT_L(0); PG8_MMA(0, 1, At, B1); PG8_BAR;
            PG8_LDA(At, 1, 1); PG8_STAGE(PG8_SA(1, 0), a3, voffA);
            PG8_BAR; PG8_WAIT_L(0); PG8_MMA(1, 0, At, B0); PG8_BAR; PG8_SCHED;
            PG8_STAGE(PG8_SB(1, 1), b3 + hstep, voffB);
            PG8_WAIT_V(6); PG8_BAR; PG8_MMA(1, 1, At, B1); PG8_BAR;
            }
        }
        if constexpr (ALIGN_EPI) { if (wr == 0) PG8_BAR; }
        if constexpr (!Epi::AFTER_DRAIN) { E(acc, cur, wr, wc, fr, fq); S.done(cur); }
        if (!has_next) break;
#pragma unroll
        for (int a = 0; a < 2; ++a)
#pragma unroll
            for (int b = 0; b < 2; ++b)
#pragma unroll
                for (int m = 0; m < 4; ++m)
#pragma unroll
                    for (int n = 0; n < 2; ++n) acc[a][b][m][n] = (f32x4){0.f, 0.f, 0.f, 0.f};
        cur = nxt; cA = nA; cB = nB; ++ui;
        if constexpr (ALIGN_EPI) { if (wr == 1) PG8_BAR; }
    }
    PG8_WAIT_V(0);
    if constexpr (!ALIGN_EPI) { if (wr == 0) PG8_BAR; }
    PG8_BAR;
    if constexpr (Epi::AFTER_DRAIN) { E.fused(acc, cur, wr, wc, fr, fq, lds, wid, lane); S.done(cur); }
#undef PG8_SA
#undef PG8_SB
#undef PG8_STAGE
#undef PG8_LDA
#undef PG8_LDB
#undef PG8_MMA
#undef PG8_WAIT_V
#undef PG8_WAIT_L
#undef PG8_BAR
#undef PG8_SCHED
}
}
#include <hip/hip_bf16.h>
#include <cmath>
namespace attn_body {
using bf16=__hip_bfloat16;
using bf16x8=__attribute__((ext_vector_type(8)))short;
using s16x4=__attribute__((ext_vector_type(4)))short;
using f32x16=__attribute__((ext_vector_type(16)))float;
using u32x4=__attribute__((ext_vector_type(4)))unsigned;
constexpr int BATCH=8,NHEAD=8,SEQ=2048,D=64,PITI=5120,PITO=512;
constexpr int NW=8,QBLK=32,QB=QBLK*NW,KVBLK=64,NQB=SEQ/QB;
constexpr int ATTN_UNIT_ROWS=QB;
__device__ __forceinline__ int crow(int r,int hi){return (r&3)+8*(r>>2)+4*hi;}
#define SBAR() __builtin_amdgcn_sched_barrier(0)
__device__ __forceinline__ void cmask(f32x16&p0,f32x16&p1,int jb,int qrel,int hi){
  const float NEG=-INFINITY; int kb=64*jb+4*hi;
  #pragma unroll
  for(int r=0;r<16;++r){int kv=kb+(r&3)+8*(r>>2); if(kv>qrel)p0[r]=NEG; if(kv+32>qrel)p1[r]=NEG;}
}

constexpr int NSLOT=3, SLOTB=8192;
constexpr int LDS_K=0, LDS_V=NSLOT*SLOTB, LDS_WS=2*NSLOT*SLOTB, LDS_OST=LDS_WS+NW*64*4, LDS_BYTES=LDS_OST+NW*4096;
constexpr float C2=0.125f*1.4426950408889634f;
__device__ __forceinline__ void glds16(const void*gsrc,unsigned lds_dst){unsigned keep;
  asm volatile("s_mov_b32 %0, m0\n\ts_mov_b32 m0, %2\n\ts_nop 0\n\tglobal_load_lds_dwordx4 %1, off\n\ts_mov_b32 m0, %0":"=&s"(keep):"v"(gsrc),"s"(lds_dst):"memory");}
__device__ __forceinline__ float max3f(float a,float b,float c){float r;asm("v_max3_f32 %0, %1, %2, %3":"=v"(r):"v"(a),"v"(b),"v"(c));return r;}
__device__ __forceinline__ float max2f(float a,float b){float r;asm("v_max_f32_e32 %0, %1, %2":"=v"(r):"v"(a),"v"(b));return r;}
__device__ __forceinline__ float fadd_s(float a,float b){float r;asm("v_add_f32_e32 %0, %1, %2":"=v"(r):"v"(a),"v"(b));return r;}
__device__ __forceinline__ float fsub_s(float a,float b){float r;asm("v_sub_f32_e32 %0, %1, %2":"=v"(r):"v"(a),"v"(b));return r;}
typedef float f32x2_t __attribute__((ext_vector_type(2))); typedef __bf16 bf16x2_t __attribute__((ext_vector_type(2)));
__device__ __forceinline__ unsigned cvtpk_s(float lo,float hi){f32x2_t v={lo,hi};bf16x2_t b=__builtin_convertvector(v,bf16x2_t);return __builtin_bit_cast(unsigned,b);}
#define WAIT_BAR(N) asm volatile("s_waitcnt vmcnt(" #N ") lgkmcnt(0)\n\ts_barrier":::"memory")

__device__ __forceinline__ void qkt(f32x16&p0,f32x16&p1,const char*Kslot,const bf16x8*qr,const f32x16&negm,int r32,int hi){
  const char*kb=Kslot+hi*1024+r32*16;
  #pragma unroll
  for(int d0=0;d0<4;++d0){
    const bf16x8 b0=*reinterpret_cast<const bf16x8*>(kb+d0*2048);
    const bf16x8 b1=*reinterpret_cast<const bf16x8*>(kb+d0*2048+512);
    if(d0==0){p0=__builtin_amdgcn_mfma_f32_32x32x16_bf16(b0,qr[0],negm,0,0,0);p1=__builtin_amdgcn_mfma_f32_32x32x16_bf16(b1,qr[0],negm,0,0,0);}
    else{p0=__builtin_amdgcn_mfma_f32_32x32x16_bf16(b0,qr[d0],p0,0,0,0);p1=__builtin_amdgcn_mfma_f32_32x32x16_bf16(b1,qr[d0],p1,0,0,0);}}
}
typedef __attribute__((address_space(3))) const char* lds_cptr;
typedef short v4i16_t __attribute__((ext_vector_type(4)));
__device__ __forceinline__ void kload8(bf16x8*kf,lds_cptr kp){
  kf[0]=*(const __attribute__((address_space(3))) bf16x8*)(kp);      kf[1]=*(const __attribute__((address_space(3))) bf16x8*)(kp+512);
  kf[2]=*(const __attribute__((address_space(3))) bf16x8*)(kp+2048); kf[3]=*(const __attribute__((address_space(3))) bf16x8*)(kp+2560);
  kf[4]=*(const __attribute__((address_space(3))) bf16x8*)(kp+4096); kf[5]=*(const __attribute__((address_space(3))) bf16x8*)(kp+4608);
  kf[6]=*(const __attribute__((address_space(3))) bf16x8*)(kp+6144); kf[7]=*(const __attribute__((address_space(3))) bf16x8*)(kp+6656);
}
__device__ __forceinline__ void kload2(bf16x8*kf,lds_cptr kp,int j){ kf[2*j]=*(const __attribute__((address_space(3))) bf16x8*)(kp+j*2048); kf[2*j+1]=*(const __attribute__((address_space(3))) bf16x8*)(kp+j*2048+512); }
__device__ __forceinline__ s16x4 vtr(lds_cptr p){ return __builtin_bit_cast(s16x4,__builtin_amdgcn_ds_read_tr16_b64_v4i16((__attribute__((address_space(3))) v4i16_t*)p)); }
__device__ __forceinline__ float rowmax(const f32x16&p0,const f32x16&p1){
  float a=max3f(p0[0],p0[1],p1[0]),b=max3f(p0[2],p0[3],p1[1]);a=max3f(a,p1[2],p1[3]);
  #pragma unroll
  for(int r=4;r<16;r+=4){a=max3f(a,p0[r],p0[r+1]);b=max3f(b,p0[r+2],p0[r+3]);a=max3f(a,p1[r],p1[r+1]);b=max3f(b,p1[r+2],p1[r+3]);}
  const float m=max2f(a,b);
  auto rr=__builtin_amdgcn_permlane32_swap(__float_as_uint(m),__float_as_uint(m),false,false);
  return max2f(__uint_as_float(rr[0]),__uint_as_float(rr[1]));
}
__device__ __forceinline__ void pv(f32x16*o,int vb,bf16x8 pa0,bf16x8 pa1,bf16x8 pa2,bf16x8 pa3){
  #pragma unroll
  for(int d0=0;d0<2;++d0){s16x4 lo[4],hi[4];
    #pragma unroll
    for(int ks=0;ks<4;++ks){
      asm volatile("ds_read_b64_tr_b16 %0,%1 offset:%c2":"=&v"(lo[ks]):"v"(vb),"i"(d0*4096+ks*1024):"memory");
      asm volatile("ds_read_b64_tr_b16 %0,%1 offset:%c2":"=&v"(hi[ks]):"v"(vb),"i"(d0*4096+ks*1024+512):"memory");}
    asm volatile("s_waitcnt lgkmcnt(0)":::"memory");SBAR();
    #define PK(k) (bf16x8){lo[k][0],lo[k][1],lo[k][2],lo[k][3],hi[k][0],hi[k][1],hi[k][2],hi[k][3]}
    o[d0]=__builtin_amdgcn_mfma_f32_32x32x16_bf16(pa0,PK(0),o[d0],0,0,0);
    o[d0]=__builtin_amdgcn_mfma_f32_32x32x16_bf16(pa1,PK(1),o[d0],0,0,0);
    o[d0]=__builtin_amdgcn_mfma_f32_32x32x16_bf16(pa2,PK(2),o[d0],0,0,0);
    o[d0]=__builtin_amdgcn_mfma_f32_32x32x16_bf16(pa3,PK(3),o[d0],0,0,0);
    #undef PK
  }
}

#ifndef ATTN_STORE16
#define ATTN_STORE16(p,v) (*(u32x4*)(p)=(v))
#endif
template<int THRL> __device__ __forceinline__ void attn_unit(int b,int h,int qb,const bf16*Q,const bf16*__restrict__ K,const bf16*__restrict__ V,bf16*O,char*shm){
  const int tid=laundered_tid(),lane=tid&63,r32=lane&31,hi=lane>>5; const int wid=__builtin_amdgcn_readfirstlane(tid>>6);
  const long rowbase=(long)b*SEQ; const int q0=qb*QB;
  const bf16*Qw=Q+(rowbase+q0+wid*QBLK)*PITI+h*D;
  const bf16*Kh=K+rowbase*PITI+h*D,*Vh=V+rowbase*PITI+h*D;
  const unsigned lds0=(unsigned)(uintptr_t)shm;
  float*wsf=(float*)(shm+LDS_WS)+wid*64;
  const bf16*ksrc=Kh+(long)lane*PITI+wid*8;
  const bf16*vsrc=Vh+(long)(16*(wid&3)+(lane>>2))*PITI+(wid>>2)*32+(lane&3)*8;
  const unsigned kdst=lds0+LDS_K+wid*1024, vdst=lds0+LDS_V+wid*1024;
  #define TROW(t) (((t)<4)?(q0+KVBLK*(t)):(KVBLK*((t)-4)))
  #define DMA_K(t,slot) glds16(ksrc+(long)TROW(t)*PITI,(unsigned)__builtin_amdgcn_readfirstlane(kdst+(slot)))
  #define DMA_V(t,slot) glds16(vsrc+(long)TROW(t)*PITI,(unsigned)__builtin_amdgcn_readfirstlane(vdst+(slot)))
  const int vb0=(int)(lds0+LDS_V)+((lane>>4)&1)*32+(lane&3)*8+(4*hi+((lane&15)>>2))*64;
  const char*Kbase=shm+LDS_K; bf16x8 kf[8];
  const lds_cptr shm3=(lds_cptr)shm; const lds_cptr kp0=shm3+LDS_K+hi*1024+r32*16; const lds_cptr vp0=shm3+LDS_V+((lane>>4)&1)*32+(lane&3)*8+(4*hi+((lane&15)>>2))*64;
  const int NT=(q0+QB)/KVBLK;
  bf16x8 qr[4];
  #pragma unroll
  for(int d0=0;d0<4;++d0)qr[d0]=*reinterpret_cast<const bf16x8*>(&Qw[(long)r32*PITI+d0*16+hi*8]);
  unsigned sel=0u;
  const float s2=__builtin_amdgcn_exp2f(-(float)(h+1))*1.4426950408889634f;
  if(qb>0){
    typedef __attribute__((address_space(3))) float* lds_fptr;
    const lds_fptr ksl=(lds_fptr)((__attribute__((address_space(3))) char*)shm+LDS_BYTES);
    if(wid<qb){
      const int rsub=lane>>3,ch=lane&7; const bf16*kp=Kh+(long)(wid*256+rsub)*PITI+ch*8;
      float a8[8];
      #pragma unroll
      for(int j=0;j<8;++j)a8[j]=0.f;
      #pragma unroll 4
      for(int i=0;i<32;++i){ const u32x4 w=*reinterpret_cast<const u32x4*>(kp+(long)i*8*PITI);
        a8[0]+=__uint_as_float(w.x<<16);a8[1]+=__uint_as_float(w.x&0xffff0000u);a8[2]+=__uint_as_float(w.y<<16);a8[3]+=__uint_as_float(w.y&0xffff0000u);
        a8[4]+=__uint_as_float(w.z<<16);a8[5]+=__uint_as_float(w.z&0xffff0000u);a8[6]+=__uint_as_float(w.w<<16);a8[7]+=__uint_as_float(w.w&0xffff0000u); }
      #pragma unroll
      for(int j=0;j<8;++j){ a8[j]+=__shfl_xor(a8[j],8); a8[j]+=__shfl_xor(a8[j],16); a8[j]+=__shfl_xor(a8[j],32); }
      if(lane<8){
        #pragma unroll
        for(int j=0;j<8;++j)ksl[wid*64+ch*8+j]=a8[j]; }
    }
    __syncthreads();
    float g[7];
    #pragma unroll
    for(int n=0;n<7;++n){ float acc=0.f;
      if(n<qb){
        #pragma unroll
        for(int d0=0;d0<4;++d0)
          #pragma unroll
          for(int j=0;j<8;++j)acc+=__uint_as_float(((unsigned)(unsigned short)qr[d0][j])<<16)*ksl[n*64+16*d0+8*hi+j];
        acc+=__shfl_xor(acc,32); }
      g[n]=acc; }
    if(qb<=3)sel=(1u<<qb)-1u;
    else{
      #pragma unroll
      for(int r=0;r<3;++r){ float best=-INFINITY; int bi=0;
        #pragma unroll
        for(int n=0;n<7;++n){ if(n<qb&&!((sel>>n)&1u)&&g[n]>best){best=g[n];bi=n;} }
        sel|=1u<<bi; } }
    __syncthreads();
  }
  DMA_K(0,0);DMA_V(0,0);DMA_K(1,SLOTB);
  float mhat=0.f,l_reg=0.f;f32x16 o[2];o[0]=f32x16{};o[1]=f32x16{};const f32x16 negm=f32x16{};
  const int qrel=wid*QBLK+r32;
  #define CMASK(P0,P1,t) do{ const int t_=(t); \
      if(t_<4){ cmask(P0,P1,t_,qrel,hi); } \
      else if(!((sel>>((t_-4)>>2))&1u)){ _Pragma("unroll") for(int r=0;r<16;++r){P0[r]=-INFINITY;P1[r]=-INFINITY;} } \
      const float tb_=s2*(float)(TROW(t_)+4*hi)-mhat; \
      _Pragma("unroll") for(int r=0;r<16;++r){ P0[r]=__builtin_fmaf((float)((r&3)+8*(r>>2)),s2,P0[r])+tb_; P1[r]=__builtin_fmaf((float)(32+(r&3)+8*(r>>2)),s2,P1[r])+tb_; } }while(0)
  bool resc=false;
  #define START(P0,P1) do{ const float rm=rowmax(P0,P1); resc=false; \
    { const float dl=rm; mhat=fadd_s(mhat,dl); \
      _Pragma("unroll") for(int r=0;r<16;++r){P0[r]=fsub_s(P0[r],dl);P1[r]=fsub_s(P1[r],dl);} \
      } \
    _Pragma("unroll") for(int r=0;r<16;++r)P0[r]=__builtin_amdgcn_exp2f(P0[r]); }while(0)
  #define RESC() do{ if(resc){ asm volatile("s_waitcnt lgkmcnt(0)":::"memory"); \
      _Pragma("unroll") for(int d_=0;d_<2;++d_) _Pragma("unroll") for(int r=0;r<16;++r)o[d_][r]*=wsf[crow(r,hi)]; } }while(0)
  f32x16 pA0,pA1,pB0,pB1;
  int sl_prev=0,sl_cur=0,sl_next=SLOTB;
  #define ROT() do{sl_prev=sl_cur;sl_cur=sl_next;sl_next=(sl_next==(NSLOT-1)*SLOTB)?0:sl_next+SLOTB;}while(0)
  DMA_K(2,2*SLOTB);
  WAIT_BAR(3);
  qkt(pA0,pA1,Kbase,qr,negm,r32,hi);asm volatile("s_nop 15\n\ts_nop 7":"+v"(pA0),"+v"(pA1));CMASK(pA0,pA1,0);
  START(pA0,pA1);
  _Pragma("unroll") for(int r=0;r<16;++r)pA1[r]=__builtin_amdgcn_exp2f(pA1[r]);
  WAIT_BAR(0);
  DMA_K(3,0);DMA_V(1,SLOTB);
  ROT();
  kload8(kf,kp0+sl_cur);
  WAIT_BAR(2);
  s16x4 vlo[8],vhi[8]; u32x4 pw0,pw1,pw2,pw3;
  #define PKW(P,B) cvtpk_s(P[B],P[B+1])
  #define PAF(k) __builtin_bit_cast(bf16x8,pw##k)
  #define VFR(i) (bf16x8){vlo[i][0],vlo[i][1],vlo[i][2],vlo[i][3],vhi[i][0],vhi[i][1],vhi[i][2],vhi[i][3]}
  #define PIN(x) asm volatile("":"+v"(x))
  #define MX3(a,b,c) __builtin_fmaxf(__builtin_fmaxf((a),(b)),(c))
  #define GAPA(MF,A0,A1,A2,A3,W0,W1,PW) do{ MF; sacc+=A0; sacc+=A1; sacc+=A2; sacc+=A3; PIN(sacc); W0; W1; PIN(PW); SBAR(); }while(0)
  #define EX(v) __builtin_amdgcn_exp2f(v)
  #define GAPB(MF,X,B) do{ MF; X[B]=EX(X[B]); X[B+1]=EX(X[B+1]); X[B+2]=EX(X[B+2]); X[B+3]=EX(X[B+3]); PIN(X); SBAR(); }while(0)
  #define VRD(i) do{ vlo[i]=vtr(vp_+(((i)>>2)*4096+((i)&3)*1024)); vhi[i]=vtr(vp_+(((i)>>2)*4096+((i)&3)*1024+512)); }while(0)
  #define KRD(G,j) do{ if(G){ kload2(kf,kp0+sl_next,j); SBAR(); } }while(0)
  #define STEP(C0,C1,P0,P1,t,GK,GV,GL) do{ SBAR(); \
    const lds_cptr vp_=vp0+sl_prev; \
    VRD(0); SBAR(); float sacc=(P0[0]+P0[1]); \
    GAPA(C0=__builtin_amdgcn_mfma_f32_32x32x16_bf16(kf[0],qr[0],negm,0,0,0), P0[2],P0[3],P0[4],P0[5],     pw0[0]=PKW(P0,0), pw0[1]=PKW(P0,2), pw0); \
    VRD(4); SBAR(); GAPA(C1=__builtin_amdgcn_mfma_f32_32x32x16_bf16(kf[1],qr[0],negm,0,0,0), P0[6],P0[7],P0[8],P0[9],     pw0[2]=PKW(P0,4), pw0[3]=PKW(P0,6), pw0); \
    VRD(1); SBAR(); GAPA(C0=__builtin_amdgcn_mfma_f32_32x32x16_bf16(kf[2],qr[1],C0,0,0,0),   P0[10],P0[11],P0[12],P0[13], pw1[0]=PKW(P0,8), pw1[1]=PKW(P0,10), pw1); \
    VRD(5); SBAR(); GAPA(C1=__builtin_amdgcn_mfma_f32_32x32x16_bf16(kf[3],qr[1],C1,0,0,0),   P0[14],P0[15],P1[0],P1[1],   pw1[2]=PKW(P0,12),pw1[3]=PKW(P0,14), pw1); \
    VRD(2); SBAR(); GAPA(C0=__builtin_amdgcn_mfma_f32_32x32x16_bf16(kf[4],qr[2],C0,0,0,0),   P1[2],P1[3],P1[4],P1[5],     pw2[0]=PKW(P1,0), pw2[1]=PKW(P1,2), pw2); \
    VRD(6); SBAR(); GAPA(C1=__builtin_amdgcn_mfma_f32_32x32x16_bf16(kf[5],qr[2],C1,0,0,0),   P1[6],P1[7],P1[8],P1[9],     pw2[2]=PKW(P1,4), pw2[3]=PKW(P1,6), pw2); \
    VRD(3); SBAR(); GAPA(C0=__builtin_amdgcn_mfma_f32_32x32x16_bf16(kf[6],qr[3],C0,0,0,0),   P1[10],P1[11],P1[12],P1[13], pw3[0]=PKW(P1,8), pw3[1]=PKW(P1,10), pw3); \
    VRD(7); SBAR(); GAPA(C1=__builtin_amdgcn_mfma_f32_32x32x16_bf16(kf[7],qr[3],C1,0,0,0),   P1[14],P1[15],0.f,0.f,       pw3[2]=PKW(P1,12),pw3[3]=PKW(P1,14), pw3); \
    l_reg+=sacc; \
    if(GK){DMA_K((t)+3,sl_cur);} if(GV){DMA_V((t)+1,sl_next);} \
    CMASK(C0,C1,t); \
    { float a=MX3(C0[0],C0[1],C1[0]),b=MX3(C0[2],C0[3],C1[1]); a=MX3(a,C1[2],C1[3]); \
      _Pragma("unroll") for(int r=4;r<16;r+=4){a=MX3(a,C0[r],C0[r+1]);b=MX3(b,C0[r+2],C0[r+3]);a=MX3(a,C1[r],C1[r+1]);b=MX3(b,C1[r+2],C1[r+3]);} \
      float rm=__builtin_fmaxf(a,b); { auto rr=__builtin_amdgcn_permlane32_swap(__float_as_uint(rm),__float_as_uint(rm),false,false); rm=__builtin_fmaxf(__uint_as_float(rr[0]),__uint_as_float(rr[1])); } \
      resc=false; \
      if(__builtin_expect(__any(rm>(float)THRL),0)){ const float dl=__builtin_fmaxf(rm,0.f); mhat+=dl; \
        _Pragma("unroll") for(int r=0;r<16;++r){C0[r]-=dl;C1[r]-=dl;} \
        const float f=__builtin_amdgcn_exp2f(-dl); l_reg*=f; if(hi==0)wsf[r32]=f; resc=true; } } \
    SBAR(); \
    GAPB(o[0]=__builtin_amdgcn_mfma_f32_32x32x16_bf16(PAF(0),VFR(0),o[0],0,0,0), C0,0); \
    GAPB(o[1]=__builtin_amdgcn_mfma_f32_32x32x16_bf16(PAF(0),VFR(4),o[1],0,0,0), C0,4); \
    KRD(GL,0); GAPB(o[0]=__builtin_amdgcn_mfma_f32_32x32x16_bf16(PAF(1),VFR(1),o[0],0,0,0), C0,8); \
    KRD(GL,1); GAPB(o[1]=__builtin_amdgcn_mfma_f32_32x32x16_bf16(PAF(1),VFR(5),o[1],0,0,0), C0,12); \
    KRD(GL,2); GAPB(o[0]=__builtin_amdgcn_mfma_f32_32x32x16_bf16(PAF(2),VFR(2),o[0],0,0,0), C1,0); \
    KRD(GL,3); GAPB(o[1]=__builtin_amdgcn_mfma_f32_32x32x16_bf16(PAF(2),VFR(6),o[1],0,0,0), C1,4); \
    GAPB(o[0]=__builtin_amdgcn_mfma_f32_32x32x16_bf16(PAF(3),VFR(3),o[0],0,0,0), C1,8); \
    GAPB(o[1]=__builtin_amdgcn_mfma_f32_32x32x16_bf16(PAF(3),VFR(7),o[1],0,0,0), C1,12); \
    }while(0)
  int t=1;
  for(;t+5<NT;t+=2){
    STEP(pB0,pB1,pA0,pA1,t,true,true,true);     WAIT_BAR(2); RESC(); ROT();
    STEP(pA0,pA1,pB0,pB1,t+1,true,true,true);   WAIT_BAR(2); RESC(); ROT();
  }
  #define ENDW(tt) do{ if((tt)+3<NT){WAIT_BAR(2);} else if((tt)+2<NT){WAIT_BAR(1);} else {WAIT_BAR(0);} }while(0)
  for(;t+1<NT;t+=2){
    STEP(pB0,pB1,pA0,pA1,t,(t+3<NT),(t+1<NT),(t+1<NT));       ENDW(t);   RESC(); ROT();
    STEP(pA0,pA1,pB0,pB1,t+1,(t+4<NT),(t+2<NT),(t+2<NT));     ENDW(t+1); RESC(); ROT();
  }
  STEP(pB0,pB1,pA0,pA1,NT-1,false,false,false); RESC();
  { float sacc=pB0[0]+pB0[1]; _Pragma("unroll") for(int r=2;r<16;++r)sacc+=pB0[r]; _Pragma("unroll") for(int r=0;r<16;++r)sacc+=pB1[r]; l_reg+=sacc;
    pw0=(u32x4){PKW(pB0,0),PKW(pB0,2),PKW(pB0,4),PKW(pB0,6)};pw1=(u32x4){PKW(pB0,8),PKW(pB0,10),PKW(pB0,12),PKW(pB0,14)};pw2=(u32x4){PKW(pB1,0),PKW(pB1,2),PKW(pB1,4),PKW(pB1,6)};pw3=(u32x4){PKW(pB1,8),PKW(pB1,10),PKW(pB1,12),PKW(pB1,14)};
    SBAR(); pv(o,vb0+sl_cur,PAF(0),PAF(1),PAF(2),PAF(3)); }
  #undef PKW
  #undef PAF
  #undef VFR
  #undef PIN
  #undef MX3
  #undef GAPA
  #undef GAPB
  #undef EX
  #undef VRD
  #undef KRD
  #undef STEP
  #undef ENDW
  {auto rr=__builtin_amdgcn_permlane32_swap(__float_as_uint(l_reg),__float_as_uint(l_reg),false,false);l_reg=__uint_as_float(rr[0])+__uint_as_float(rr[1]);}
  if(hi==0)wsf[32+r32]=l_reg;asm volatile("s_waitcnt lgkmcnt(0)":::"memory");
  float rli[16];
  #pragma unroll
  for(int r=0;r<16;++r)rli[r]=__builtin_amdgcn_rcpf(wsf[32+crow(r,hi)]);
  bf16*Ow=O+(rowbase+q0+wid*QBLK)*PITO+h*D;
  { bf16*stg=(bf16*)(shm+LDS_OST)+wid*2048;
    #pragma unroll
    for(int r=0;r<16;++r){const int orow=crow(r,hi);
      #pragma unroll
      for(int d0=0;d0<2;++d0)stg[orow*64+d0*32+r32]=__float2bfloat16(o[d0][r]*rli[r]);}
    asm volatile("s_waitcnt lgkmcnt(0)":::"memory");
    #pragma unroll
    for(int i=0;i<4;++i){const int row=i*8+(lane>>3),ch=lane&7; const u32x4 v=*(const u32x4*)(stg+row*64+ch*8); ATTN_STORE16(Ow+(long)row*PITO+ch*8,v);} }
  asm volatile("s_waitcnt lgkmcnt(0)\n\ts_barrier":::"memory");
  #undef DMA_K
  #undef DMA_V
  #undef CMASK
  #undef START
  #undef RESC
  #undef ROT
}
constexpr int ATTN_LDS_BYTES=LDS_BYTES;
template<int THRL=8> __device__ __forceinline__ void attn_phase(char*lds,const bf16*proj,bf16*ya,int vcu,int G){
  for(int u=vcu;u<512;u+=G){ const int bh=(u&255)>>2,s=u&3,qb=(u<256)?7-s:s;
    attn_unit<THRL>(bh/NHEAD,bh%NHEAD,qb,proj,proj+512,proj+1024,ya,lds); }
}
#undef SBAR
#undef WAIT_BAR
}

constexpr int NWAVES = 8;
constexpr int RING_OFF = 0, RING_BYTES = 131072;
constexpr int LDSCTL_OFF = RING_BYTES, MISC_OFF = LDSCTL_OFF + 320;
constexpr int LDS_BYTES = 147456;
constexpr int CW_BAR = 4096;

typedef unsigned v4u __attribute__((ext_vector_type(4)));
typedef unsigned v2u __attribute__((ext_vector_type(2)));
typedef float f32x4 __attribute__((ext_vector_type(4)));
typedef GAS unsigned gu32;
#define RLX_AGENT __ATOMIC_RELAXED, __HIP_MEMORY_SCOPE_AGENT
#define LDS_WAIT() asm volatile("s_waitcnt lgkmcnt(0)" ::: "memory")
#define VM_WAIT() asm volatile("s_waitcnt vmcnt(0)" ::: "memory")

#define XB_TMO      128
#define XB_XCNT(j)  (256  + 64 * (j))
#define XB_XSUB(j)  (1280 + 64 * (j))
#define XB_XGEN(j)  (2304 + 64 * (j))
#define XB_TOP      3328
#define XB_TOPGEN   3392
#define XCD_BAR_WORDS 3456
#define XB_SPIN_CAP (1u << 22)
__device__ __forceinline__ unsigned xb_ld(unsigned* p)              { return __hip_atomic_load(p, __ATOMIC_RELAXED, __HIP_MEMORY_SCOPE_AGENT); }
__device__ __forceinline__ unsigned xb_add(unsigned* p, unsigned v) { return __hip_atomic_fetch_add(p, v, __ATOMIC_RELAXED, __HIP_MEMORY_SCOPE_AGENT); }
__device__ __forceinline__ unsigned xb_xcc_id() { return (unsigned)__builtin_amdgcn_s_getreg((3 << 11) | 20) & 0xFu; }
#define XB_SPIN(cond, bar) do { unsigned _sp = 0; while (cond) { __builtin_amdgcn_s_sleep(1); \
    if ((++_sp & 255u) == 0u) { if (xb_ld(&(bar)[XB_TMO])) break; if (_sp > XB_SPIN_CAP) { atomicAdd(&(bar)[XB_TMO], 1u); break; } } } } while (0)
struct XcdBarrier { unsigned* bar; unsigned x; volatile LAS unsigned* st; };
__device__ __forceinline__ XcdBarrier xcd_barrier_post(unsigned* bar, volatile LAS unsigned* st) {
    XcdBarrier b; b.bar = bar; b.x = xb_xcc_id(); b.st = st;
    if (threadIdx.x == 0) (void)xb_add(&bar[XB_XCNT(b.x)], 1u);
    return b;
}
__device__ __forceinline__ void xcd_barrier_complete(unsigned* bar, unsigned x, unsigned& nloc, unsigned& nx) {
    const unsigned G = gridDim.x * gridDim.y * gridDim.z;
    unsigned sum, cnt, mine, sp = 0u;
    for (;;) {
        sum = 0u; cnt = 0u; mine = 0u;
#pragma unroll
        for (unsigned j = 0; j < 16; ++j) { const unsigned c = xb_ld(&bar[XB_XCNT(j)]); sum += c; cnt += (c > 0u) ? 1u : 0u; mine = (j == x) ? c : mine; }
        if (sum == G) break;
        __builtin_amdgcn_s_sleep(1);
        if ((++sp & 255u) == 0u) { if (xb_ld(&bar[XB_TMO])) break; if (sp > XB_SPIN_CAP) { atomicAdd(&bar[XB_TMO], 1u); break; } }
    }
    nloc = mine > 0u ? mine : 1u; nx = cnt > 0u ? cnt : 1u;
}
__device__ __forceinline__ void xcd_barrier(const XcdBarrier& b) {
    asm volatile("s_waitcnt vmcnt(0)" ::: "memory");
    __syncthreads();
    if (threadIdx.x == 0) {
        unsigned* bar = b.bar;
        __builtin_amdgcn_s_waitcnt(0);
        unsigned nloc = b.st[0], nx = b.st[1];
        if (nloc == 0u) { xcd_barrier_complete(bar, b.x, nloc, nx); b.st[0] = nloc; b.st[1] = nx; }
        const unsigned old = xb_add(&bar[XB_XSUB(b.x)], 1u);
        const unsigned gen = old / nloc;
        if (old + 1u == (gen + 1u) * nloc) {
            __builtin_amdgcn_fence(__ATOMIC_RELEASE, "agent");
            asm volatile("s_waitcnt vmcnt(0)" ::: "memory");
            const unsigned og = xb_add(&bar[XB_TOP], 1u);
            const unsigned tg = og / nx;
            if (og + 1u == (tg + 1u) * nx) xb_add(&bar[XB_TOPGEN], 1u);
            else XB_SPIN(xb_ld(&bar[XB_TOPGEN]) == tg, bar);
            __builtin_amdgcn_fence(__ATOMIC_ACQUIRE, "agent");
            xb_add(&bar[XB_XGEN(b.x)], 1u);
            asm volatile("s_waitcnt vmcnt(0)" ::: "memory");
        } else {
            XB_SPIN(xb_ld(&bar[XB_XGEN(b.x)]) == gen, bar);
            __builtin_amdgcn_fence(__ATOMIC_ACQUIRE, "agent");
            asm volatile("s_waitcnt vmcnt(0)" ::: "memory");
        }
    }
    __syncthreads();
}

struct Frame {
    LAS unsigned char* lds;
    int tid, lane, wave, vcu, G;
};

__device__ __forceinline__ void p0_transpose_item(const float* W, int K, int N, bf16_t* WT, LAS float* scr, int item, int lane) {
    const int nblk = N / 32, kb = item / nblk, nb = item % nblk, k0 = 64 * kb, n0 = 32 * nb;
#pragma unroll 8
    for (int i = 0; i < 32; ++i) { const int kk = 2 * i + (lane >> 5); scr[kk * 33 + (lane & 31)] = W[(size_t)(k0 + kk) * N + n0 + (lane & 31)]; }
    LDS_WAIT(); asm volatile("" ::: "memory");
    const int c = lane & 7;
#pragma unroll
    for (int j = 0; j < 4; ++j) { const int n = (lane >> 3) + 8 * j; const LAS float* s = scr + (8 * c) * 33 + n;
        v4u o; o.x = pk2(s[0 * 33], s[1 * 33]); o.y = pk2(s[2 * 33], s[3 * 33]); o.z = pk2(s[4 * 33], s[5 * 33]); o.w = pk2(s[6 * 33], s[7 * 33]);
        *(GAS v4u*)(WT + (size_t)(n0 + n) * K + k0 + 8 * c) = o; }
    LDS_WAIT(); asm volatile("" ::: "memory");
}
__device__ __forceinline__ void p0_cvt_item(const float* src, bf16_t* dst, size_t item, int lane) {
    const GAS f32x4* s = (const GAS f32x4*)(src + item * 2048) + lane;
    f32x4 v[8];
#pragma unroll
    for (int j = 0; j < 8; ++j) v[j] = __builtin_nontemporal_load(s + 64 * j);
    GAS v2u* d = (GAS v2u*)(dst + item * 2048) + lane;
#pragma unroll
    for (int j = 0; j < 8; ++j) { v2u o; o.x = pk2(v[j].x, v[j].y); o.y = pk2(v[j].z, v[j].w); d[64 * j] = o; }
}
__device__ __forceinline__ void p0_fp8_row(const float* src, unsigned char* dst, float* scale_out, int lane) {
    const GAS f32x4* s = (const GAS f32x4*)src + lane;
    f32x4 v[4]; float am = 0.f;
#pragma unroll
    for (int j = 0; j < 4; ++j) { v[j] = __builtin_nontemporal_load(s + 64 * j); am = fmaxf(fmaxf(am, fmaxf(fabsf(v[j].x), fabsf(v[j].y))), fmaxf(fabsf(v[j].z), fabsf(v[j].w))); }
    am = wave_max(am);
    const float inv = am > 0.f ? 440.0f / am : 0.f;
#pragma unroll
    for (int j = 0; j < 4; ++j) { int w = 0; w = __builtin_amdgcn_cvt_pk_fp8_f32(v[j].x * inv, v[j].y * inv, w, false); w = __builtin_amdgcn_cvt_pk_fp8_f32(v[j].z * inv, v[j].w * inv, w, true);
        *(GAS unsigned*)(dst + 256 * j + 16 * (lane & 15) + 4 * (lane >> 4)) = (unsigned)w; }
    if (lane == 0) *scale_out = am * (1.0f / 440.0f);
}
struct P0Args { const float *c, *w_ada, *b_ada, *w_in, *w_ap, *w_cp, *w_out, *w_q, *sk, *eu, *ev; unsigned char* ws; };
__device__ __forceinline__ void p0_prologue(const Frame& F, const P0Args& a) {
    LAS float* scr = (LAS float*)(F.lds + RING_OFF + F.wave * 16384);
    const int gw = F.vcu * NWAVES + F.wave, NGW = F.G * NWAVES;
    {
        constexpr int NB = 6 * D / 64, KLEN = D / NWAVES;
        float* ada = (float*)(a.ws + WS_ADA);
        LAS float* red = (LAS float*)(F.lds + RING_OFF + F.wave * 16384 + 12288);
        for (int it = F.vcu; it < DEPTH * NB; it += F.G) {
            const int l = it / NB, nb = it % NB, n = nb * 64 + F.lane, k0 = F.wave * KLEN;
            const float* w = a.w_ada + (size_t)l * D * 6 * D + (size_t)k0 * 6 * D + n;
            float acc[BATCH];
#pragma unroll
            for (int b = 0; b < BATCH; ++b) acc[b] = 0.f;
#pragma unroll 8
            for (int k = 0; k < KLEN; ++k) { const float wv = w[(size_t)k * 6 * D];
#pragma unroll
                for (int b = 0; b < BATCH; ++b) acc[b] += a.c[b * D + k0 + k] * wv; }
#pragma unroll
            for (int b = 0; b < BATCH; ++b) red[b * 64 + F.lane] = acc[b];
            __syncthreads();
            { const int b = F.wave; float sum = a.b_ada[l * 6 * D + n];
#pragma unroll
              for (int w2 = 0; w2 < NWAVES; ++w2) sum += ((LAS float*)(F.lds + RING_OFF + w2 * 16384 + 12288))[b * 64 + F.lane];
              ada[((size_t)l * BATCH + b) * 6 * D + n] = sum; }
            __syncthreads();
        }
    }
    {
        constexpr int I_IN = (D / 64) * (INC / 32), I_AP = (512 / 64) * (D / 32), I_OUT = (D / 64) * (D / 32), I_Q = (D / 64) * (QPW / 32);
        constexpr int PER_L = I_IN + 2 * I_AP + I_OUT + I_Q;
        for (int it = gw; it < DEPTH * PER_L; it += NGW) {
            const int l = it / PER_L; int r = it % PER_L;
            if (r < I_IN) { p0_transpose_item(a.w_in + (size_t)l * D * INC, D, INC, (bf16_t*)(a.ws + WS_WIN) + (size_t)l * INC * D, scr, r, F.lane); continue; } r -= I_IN;
            if (r < I_AP) { p0_transpose_item(a.w_ap + (size_t)l * 512 * D, 512, D, (bf16_t*)(a.ws + WS_WAP) + (size_t)l * D * 512, scr, r, F.lane); continue; } r -= I_AP;
            if (r < I_AP) { p0_transpose_item(a.w_cp + (size_t)l * 512 * D, 512, D, (bf16_t*)(a.ws + WS_WCP) + (size_t)l * D * 512, scr, r, F.lane); continue; } r -= I_AP;
            if (r < I_OUT) { p0_transpose_item(a.w_out + (size_t)l * D * D, D, D, (bf16_t*)(a.ws + WS_WOUT) + (size_t)l * D * D, scr, r, F.lane); continue; } r -= I_OUT;
            p0_transpose_item(a.w_q + (size_t)l * D * QPW, D, QPW, (bf16_t*)(a.ws + WS_WQ) + (size_t)l * QPW * D, scr, r, F.lane);
        }
    }
    {
        constexpr size_t I_SK = (size_t)DEPTH * 16 * NKEY * HALFK / 2048;
        for (size_t it = gw; it < I_SK; it += NGW) p0_cvt_item(a.sk, (bf16_t*)(a.ws + WS_SK), it, F.lane);
        constexpr int NROWS = 2 * DEPTH * NEXP;
        for (int r = gw; r < NROWS; r += NGW) {
            const bool isv = r >= DEPTH * NEXP; const int rr = isv ? r - DEPTH * NEXP : r;
            p0_fp8_row((isv ? a.ev : a.eu) + (size_t)rr * D, a.ws + (isv ? WS_EV : WS_EU) + (size_t)rr * D, (float*)(a.ws + (isv ? WS_ESV : WS_ESU)) + rr, F.lane);
        }
    }
}

__device__ __forceinline__ void norm_row(const float* xr, const float* g, const float* sh, const float* sc, bf16_t* orow, int lane) {
    const GAS f32x4* xp = (const GAS f32x4*)xr + lane;
    f32x4 v[4]; float ss = 0.f;
#pragma unroll
    for (int j = 0; j < 4; ++j) { v[j] = xp[64 * j]; ss += (v[j].x * v[j].x + v[j].y * v[j].y) + (v[j].z * v[j].z + v[j].w * v[j].w); }
    const float r = rsqrtf(wave_sum(ss) * (1.0f / D) + EPS);
    GAS v2u* o8 = (GAS v2u*)orow + lane;
#pragma unroll
    for (int j = 0; j < 4; ++j) {
        const f32x4 gv = *((const f32x4*)g + lane + 64 * j), sv = *((const f32x4*)sc + lane + 64 * j), hv = *((const f32x4*)sh + lane + 64 * j);
        const f32x4 y = v[j] * r * gv * (sv + 1.0f) + hv;
        v2u o; o.x = pk2(y.x, y.y); o.y = pk2(y.z, y.w); o8[64 * j] = o; }
}
__device__ __forceinline__ void norm_phase(const Frame& F, const float* x, const float* g, const float* ada_l, int sh_off, int sc_off, bf16_t* H) {
    const int gw = F.vcu * NWAVES + F.wave, NGW = F.G * NWAVES;
    for (int m = gw; m < M; m += NGW) { const float* ab = ada_l + (size_t)(m / SEQ) * 6 * D; norm_row(x + (size_t)m * D, g, ab + sh_off, ab + sc_off, H + (size_t)m * D, F.lane); }
}

__device__ __forceinline__ void conv_phase(const Frame& F, const bf16_t* proj, const float* cw, bf16_t* yc) {
    const int gw = F.vcu * NWAVES + F.wave, NGW = F.G * NWAVES, ch0 = F.lane * 8;
    float w0[8], w1[8], w2[8];
#pragma unroll
    for (int j = 0; j < 8; ++j) { w0[j] = cw[ch0 + j]; w1[j] = cw[512 + ch0 + j]; w2[j] = cw[1024 + ch0 + j]; }
    for (int m = gw; m < M; m += NGW) {
        const int t = m % SEQ; const bf16_t* pr = proj + (size_t)m * INC;
        const v4u bg = *(const v4u*)(pr + OBG + ch0);
        const v4u c2 = *(const v4u*)(pr + OCG + ch0), h2 = *(const v4u*)(pr + OHC + ch0);
        v4u c1 = (v4u){0u, 0u, 0u, 0u}, h1 = c1, c0 = c1, h0 = c1;
        if (t >= 1) { c1 = *(const v4u*)(pr - INC + OCG + ch0); h1 = *(const v4u*)(pr - INC + OHC + ch0); }
        if (t >= 2) { c0 = *(const v4u*)(pr - 2 * INC + OCG + ch0); h0 = *(const v4u*)(pr - 2 * INC + OHC + ch0); }
        float y[8];
#pragma unroll
        for (int q = 0; q < 4; ++q) {
            y[2 * q]     = bflo(bg[q]) * (w0[2 * q] * bflo(c0[q]) * bflo(h0[q]) + w1[2 * q] * bflo(c1[q]) * bflo(h1[q]) + w2[2 * q] * bflo(c2[q]) * bflo(h2[q]));
            y[2 * q + 1] = bfhi(bg[q]) * (w0[2 * q + 1] * bfhi(c0[q]) * bfhi(h0[q]) + w1[2 * q + 1] * bfhi(c1[q]) * bfhi(h1[q]) + w2[2 * q + 1] * bfhi(c2[q]) * bfhi(h2[q]));
        }
        v4u o; o.x = pk2(y[0], y[1]); o.y = pk2(y[2], y[3]); o.z = pk2(y[4], y[5]); o.w = pk2(y[6], y[7]);
        *(v4u*)(yc + (size_t)m * 512 + ch0) = o;
    }
}

#if !USE_NAIVE_AT
__device__ __forceinline__ void attn_phase_all(const Frame& F, const bf16_t* proj, bf16_t* ya) {
    static_assert(attn_body::ATTN_LDS_BYTES + 2048 <= RING_BYTES, "attention scratch fits the ring region");
    attn_body::attn_phase<8>((char*)(F.lds + RING_OFF), (const attn_body::bf16*)proj, (attn_body::bf16*)ya, F.vcu, F.G);
}
#endif

#if !USE_NAIVE_TK
namespace tk {
typedef short bf16x8 __attribute__((ext_vector_type(8)));
typedef float f32x16 __attribute__((ext_vector_type(16)));
__device__ __forceinline__ unsigned umax_(unsigned a, unsigned b) { return a > b ? a : b; }
__device__ __forceinline__ unsigned umin_(unsigned a, unsigned b) { return a < b ? a : b; }
template <unsigned TAGMASK> __device__ __forceinline__ unsigned f2key(float f, unsigned tag) { unsigned u = __float_as_uint(f); u = (u & 0x80000000u) ? ~u : (u | 0x80000000u); return (u & ~TAGMASK) | tag; }
template <unsigned TAGMASK> __device__ __forceinline__ float key2f(unsigned k) { unsigned v = k & ~TAGMASK; v = (v & 0x80000000u) ? (v & 0x7fffffffu) : ~v; return __uint_as_float(v); }
template <int O> __device__ __forceinline__ void sort16(unsigned (&v)[64]) {
#pragma unroll
    for (int k = 2; k <= 16; k <<= 1)
#pragma unroll
        for (int j = k >> 1; j > 0; j >>= 1)
#pragma unroll
            for (int i = 0; i < 16; ++i) { const int l = i ^ j; if (l > i) { const unsigned mx = umax_(v[O + i], v[O + l]), mn = umin_(v[O + i], v[O + l]); const bool desc = ((i & k) == 0); v[O + i] = desc ? mx : mn; v[O + l] = desc ? mn : mx; } }
}
template <int O> __device__ __forceinline__ void bitonic_merge16(unsigned (&v)[64]) {
#pragma unroll
    for (int j = 8; j > 0; j >>= 1)
#pragma unroll
        for (int i = 0; i < 16; ++i) { const int l = i ^ j; if (l > i) { const unsigned mx = umax_(v[O + i], v[O + l]), mn = umin_(v[O + i], v[O + l]); v[O + i] = mx; v[O + l] = mn; } }
}
template <int A, int B> __device__ __forceinline__ void merge_top16(unsigned (&v)[64]) {
#pragma unroll
    for (int i = 0; i < 16; ++i) v[A + i] = umax_(v[A + i], v[B + 15 - i]);
    bitonic_merge16<A>(v);
}
__device__ __forceinline__ void top16_of_64(unsigned (&v)[64]) {
    sort16<0>(v); sort16<16>(v); sort16<32>(v); sort16<48>(v);
    merge_top16<0, 16>(v); merge_top16<32, 48>(v); merge_top16<0, 32>(v);
}
__device__ __forceinline__ void merge_halves(unsigned (&v)[64]) {
#pragma unroll
    for (int i = 0; i < 16; ++i) { auto rr = __builtin_amdgcn_permlane32_swap(v[i], v[i], false, false); v[16 + i] = rr[0]; v[32 + i] = rr[1]; }
#pragma unroll
    for (int i = 0; i < 16; ++i) v[i] = umax_(v[16 + i], v[32 + 15 - i]);
    bitonic_merge16<0>(v);
}
__device__ __forceinline__ int crow(int r, int hi) { return (r & 3) + 8 * (r >> 2) + 4 * hi; }

constexpr int SK_PITCH = 272;
__device__ __forceinline__ void group_top16(const bf16_t* qp, const LAS unsigned char* skl, int row0, int gp, int r32, int hi, unsigned (&out)[16]) {
    bf16x8 bq[8];
    const bf16_t* qrow = qp + (size_t)(row0 + r32) * QPW + gp * 128 + hi * 8;
#pragma unroll
    for (int ks = 0; ks < 8; ++ks) bq[ks] = *(const bf16x8*)(qrow + ks * 16);
    unsigned v[64];
#pragma unroll
    for (int kb = 0; kb < 4; ++kb) {
        unsigned koff = (unsigned)((kb * 32 + r32) * SK_PITCH + hi * 16);
        asm volatile("" : "+v"(koff));
        const LAS unsigned char* kl = skl + koff;
        f32x16 acc = f32x16{};
#pragma unroll
        for (int ks = 0; ks < 8; ++ks) { const bf16x8 a = *(const LAS bf16x8*)(kl + ks * 32); acc = __builtin_amdgcn_mfma_f32_32x32x16_bf16(a, bq[ks], acc, 0, 0, 0); }
#pragma unroll
        for (int r = 0; r < 16; ++r) v[kb * 16 + r] = f2key<0x7fu>(acc[r], 127u - (unsigned)(kb * 32 + crow(r, hi)));
    }
    top16_of_64(v);
    merge_halves(v);
#pragma unroll
    for (int i = 0; i < 16; ++i) out[i] = v[i];
}
constexpr int cand_before(int i) { int s = 0; for (int a = 0; a < i; ++a) s += 16 / (a + 1); return s; }
}

__device__ __forceinline__ void topk_phase(const Frame& F, const bf16_t* qp, const bf16_t* sk, int* eidx, float* egate) {
    const int r32 = F.lane & 31, hi = F.lane >> 5, hh = F.vcu & 7, cg = F.vcu >> 3, ncg = F.G >> 3;
    LAS unsigned char* skl = F.lds + RING_OFF;
    for (int pc = F.tid; pc < 256 * 16; pc += NWAVES * 64) { const int rowk = pc >> 4, ch = pc & 15;
        *(LAS v4u*)(skl + rowk * tk::SK_PITCH + ch * 16) = *(const v4u*)(sk + (size_t)(2 * hh * 128 + rowk) * HALFK + ch * 8); }
    __syncthreads();
    for (int tile = cg + ncg * F.wave; tile < M / 32; tile += ncg * NWAVES) {
        const int row0 = tile * 32;
        unsigned L0[16], L1[16];
        tk::group_top16(qp, skl, row0, 2 * hh, r32, hi, L0);
        tk::group_top16(qp, skl + 128 * tk::SK_PITCH, row0, 2 * hh + 1, r32, hi, L1);
        float f0[16], f1[16]; unsigned long long p0lo = 0ull, p0hi = 0ull, p1lo = 0ull, p1hi = 0ull;
#pragma unroll
        for (int i = 0; i < 16; ++i) {
            f0[i] = tk::key2f<0x7fu>(L0[i]); f1[i] = tk::key2f<0x7fu>(L1[i]);
            const unsigned long long i0 = 127u - (L0[i] & 127u), i1 = 127u - (L1[i] & 127u);
            if (i < 8) { p0lo |= i0 << (8 * i); p1lo |= i1 << (8 * i); } else { p0hi |= i0 << (8 * (i - 8)); p1hi |= i1 << (8 * (i - 8)); }
        }
        unsigned cv[64];
#pragma unroll
        for (int q = 0; q < 64; ++q) cv[q] = 0u;
#pragma unroll
        for (int i = 0; i < 16; ++i)
#pragma unroll
            for (int j = 0; j < 16; ++j) if ((i + 1) * (j + 1) <= 16) cv[tk::cand_before(i) + j] = tk::f2key<0xffu>(f0[i] + f1[j], 255u - (unsigned)(i * 16 + j));
        tk::top16_of_64(cv);
        float bv[16], sum = 0.f; int ex[16];
        const float mx = tk::key2f<0xffu>(cv[0]);
#pragma unroll
        for (int r = 0; r < 16; ++r) {
            bv[r] = __expf(tk::key2f<0xffu>(cv[r]) - mx); sum += bv[r];
            const unsigned pos = 255u - (cv[r] & 255u), i = pos >> 4, j = pos & 15u;
            const unsigned e0 = (unsigned)(((i < 8u) ? p0lo : p0hi) >> (8u * (i & 7u))) & 127u;
            const unsigned e1 = (unsigned)(((j < 8u) ? p1lo : p1hi) >> (8u * (j & 7u))) & 127u;
            ex[r] = (int)(e0 * NKEY + e1);
        }
        const float inv = __builtin_amdgcn_rcpf(sum);
        int eo[8]; float go[8];
#pragma unroll
        for (int k = 0; k < 8; ++k) { eo[k] = hi ? ex[8 + k] : ex[k]; go[k] = (hi ? bv[8 + k] : bv[k]) * inv; }
        const size_t ob = (size_t)(row0 + r32) * 128 + hh * 16 + 8 * hi;
        *(int4*)(eidx + ob) = make_int4(eo[0], eo[1], eo[2], eo[3]); *(int4*)(eidx + ob + 4) = make_int4(eo[4], eo[5], eo[6], eo[7]);
        *(float4*)(egate + ob) = make_float4(go[0], go[1], go[2], go[3]); *(float4*)(egate + ob + 4) = make_float4(go[4], go[5], go[6], go[7]);
    }
    __syncthreads();
}
#endif

#if !USE_NAIVE_PE
namespace pe {
typedef __bf16 bf16x2v __attribute__((ext_vector_type(2)));
typedef float f32x2 __attribute__((ext_vector_type(2)));
__device__ __forceinline__ unsigned umax_(unsigned a, unsigned b) { return a > b ? a : b; }
__device__ __forceinline__ unsigned umin_(unsigned a, unsigned b) { return a < b ? a : b; }
__device__ __forceinline__ void sort128(unsigned (&v)[8], int i) {
#pragma unroll
    for (int k = 2; k <= 128; k <<= 1)
#pragma unroll
        for (int j = k >> 1; j > 0; j >>= 1) {
            if (j < 8) {
#pragma unroll
                for (int r = 0; r < 8; ++r) { const int q = r ^ j; if (q > r) {
                    const unsigned lo = umin_(v[r], v[q]), hi = umax_(v[r], v[q]);
                    const bool asc = (k < 8) ? ((r & k) == 0) : ((i & (k >> 3)) == 0);
                    v[r] = asc ? lo : hi; v[q] = asc ? hi : lo; } }
            } else {
                const int m = j >> 3; const bool lower = (i & m) == 0, asc = (i & (k >> 3)) == 0, keepmin = (lower == asc);
#pragma unroll
                for (int r = 0; r < 8; ++r) { const unsigned o = (unsigned)__shfl_xor((int)v[r], m); v[r] = keepmin ? umin_(v[r], o) : umax_(v[r], o); }
            }
        }
}
struct URow { v4u u[4]; float su, gs; };
struct VRow { v4u v[4]; };
__device__ __forceinline__ float group_sum16(float d) { d += __shfl_xor(d, 1); d += __shfl_xor(d, 2); d += __shfl_xor(d, 4); d += __shfl_xor(d, 8); return d; }
}

__device__ __forceinline__ void peer_phase(const Frame& F, int l, const bf16_t* H, const float* x1, const int* eidx, const float* egate, const unsigned char* eu, const unsigned char* ev, const float* esu, const float* esv, const float* ada_l, const float* final_g, float* out, const float* nx_g, const float* nx_ada, bf16_t* Hn) {
    const int gw = F.vcu * NWAVES + F.wave, lane = F.lane, g = lane >> 4;
    const bool fin = (l == DEPTH - 1);
    for (int row0 = gw * 8; row0 < M; row0 += F.G * NWAVES * 8)
#pragma unroll 1
    for (int rnd = 0; rnd < 2; ++rnd) {
        int il_ = lane & 15; asm volatile("" : "+v"(il_));
        const int i = il_, row = row0 + 4 * rnd + g;
        unsigned key[8]; float ck[8];
#pragma unroll
        for (int r = 0; r < 8; ++r) { const int x = r * 16 + i; key[r] = ((unsigned)eidx[(size_t)row * 128 + x] << 7) | (unsigned)x; ck[r] = 0.f; }
#ifndef PE_SKIP_SORT
        pe::sort128(key, i);
#endif
        {
            unsigned hh[32];
#pragma unroll
            for (int k = 0; k < 4; ++k)
#pragma unroll
                for (int dd = 0; dd < 4; ++dd) { const v2u hw = *(const v2u*)(H + (size_t)row * D + 256 * k + 64 * dd + 4 * i); hh[8 * k + 2 * dd] = hw.x; hh[8 * k + 2 * dd + 1] = hw.y; }
            const unsigned char* eub = eu + 16 * i;
#define PE_LD1(P, li, R) do { const unsigned k_ = (unsigned)__shfl((int)key[R], (lane & 48) | (li)); const unsigned e_ = k_ >> 7; \
            _Pragma("unroll") for (int k = 0; k < 4; ++k) P.u[k] = *(const v4u*)(eub + (size_t)e_ * D + 256 * k); P.su = esu[e_]; P.gs = grow[k_ & 127u] * esv[e_]; } while (0)
#define PE_DOT(P, d_) do { d_ = 0.f; \
            _Pragma("unroll") for (int k = 0; k < 4; ++k) _Pragma("unroll") for (int dd = 0; dd < 4; ++dd) { \
                const pe::bf16x2v ul_ = __builtin_amdgcn_cvt_scalef32_pk_bf16_fp8(P.u[k][dd], 1.0f, false), uh_ = __builtin_amdgcn_cvt_scalef32_pk_bf16_fp8(P.u[k][dd], 1.0f, true); \
                d_ = __builtin_amdgcn_fdot2_f32_bf16(ul_, __builtin_bit_cast(pe::bf16x2v, hh[8 * k + 2 * dd]), d_, false); \
                d_ = __builtin_amdgcn_fdot2_f32_bf16(uh_, __builtin_bit_cast(pe::bf16x2v, hh[8 * k + 2 * dd + 1]), d_, false); } } while (0)
            pe::URow X0, X1, X2, X3;
            const float* grow = egate + (size_t)row * 128;
#define PE_STEP(Xc, Xn, p0, U) do { PE_LD1(Xn, (((p0) + (U) + 3) >> 3) & 15, ((U) + 3) & 7);     \
            float d_; PE_DOT(Xc, d_); d_ = pe::group_sum16(d_); const float c_ = gelu_tanh(d_ * Xc.su) * Xc.gs; ck[U] = (i == ((p0) >> 3)) ? c_ : ck[U]; } while (0)
            PE_LD1(X0, 0, 0); PE_LD1(X1, 0, 1); PE_LD1(X2, 0, 2);
#pragma unroll 1
            for (int p0 = 0; p0 < 128; p0 += 8) {
                PE_STEP(X0, X3, p0, 0); PE_STEP(X1, X0, p0, 1); PE_STEP(X2, X1, p0, 2); PE_STEP(X3, X2, p0, 3);
                PE_STEP(X0, X3, p0, 4); PE_STEP(X1, X0, p0, 5); PE_STEP(X2, X1, p0, 6); PE_STEP(X3, X2, p0, 7);
            }
#undef PE_STEP
#undef PE_LD1
#undef PE_DOT
        }
        pe::f32x2 acc[32];
#pragma unroll
        for (int q = 0; q < 32; ++q) acc[q] = (pe::f32x2){0.f, 0.f};
        {
            const unsigned char* evb = ev + 16 * i;
#define PE_LD1(P, li, R) do { const unsigned e_ = (unsigned)__shfl((int)key[R], (lane & 48) | (li)) >> 7; \
            _Pragma("unroll") for (int k = 0; k < 4; ++k) P.v[k] = *(const v4u*)(evb + (size_t)e_ * D + 256 * k); } while (0)
#define PE_STEP(Xc, Xn, p0, U) do { PE_LD1(Xn, (((p0) + (U) + 3) >> 3) & 15, ((U) + 3) & 7);     \
            const float c_ = __shfl(ck[U], (lane & 48) | ((p0) >> 3)); const pe::f32x2 cc_ = (pe::f32x2){c_, c_}; \
            _Pragma("unroll") for (int k = 0; k < 4; ++k) _Pragma("unroll") for (int dd = 0; dd < 4; ++dd) { \
                acc[8 * k + 2 * dd] += cc_ * __builtin_amdgcn_cvt_pk_f32_fp8((int)Xc.v[k][dd], false); acc[8 * k + 2 * dd + 1] += cc_ * __builtin_amdgcn_cvt_pk_f32_fp8((int)Xc.v[k][dd], true); } } while (0)
            pe::VRow X0, X1, X2, X3;
            PE_LD1(X0, 0, 0); PE_LD1(X1, 0, 1); PE_LD1(X2, 0, 2);
#pragma unroll 1
            for (int p0 = 0; p0 < 128; p0 += 8) {
                PE_STEP(X0, X3, p0, 0); PE_STEP(X1, X0, p0, 1); PE_STEP(X2, X1, p0, 2); PE_STEP(X3, X2, p0, 3);
                PE_STEP(X0, X3, p0, 4); PE_STEP(X1, X0, p0, 5); PE_STEP(X2, X1, p0, 6); PE_STEP(X3, X2, p0, 7);
            }
#undef PE_STEP
#undef PE_LD1
        }
        const float* g2 = ada_l + (size_t)(row / SEQ) * 6 * D + 5 * D;
        float ss = 0.f;
#pragma unroll
        for (int k = 0; k < 4; ++k)
#pragma unroll
            for (int dd = 0; dd < 4; ++dd) { const int col = 256 * k + 64 * dd + 4 * i;
                const f32x4 xv = *(const f32x4*)(x1 + (size_t)row * D + col), gv = *(const f32x4*)(g2 + col);
                const f32x4 o = xv + gv * (f32x4){acc[8 * k + 2 * dd].x, acc[8 * k + 2 * dd].y, acc[8 * k + 2 * dd + 1].x, acc[8 * k + 2 * dd + 1].y};
                acc[8 * k + 2 * dd] = (pe::f32x2){o.x, o.y}; acc[8 * k + 2 * dd + 1] = (pe::f32x2){o.z, o.w};
                ss += (o.x * o.x + o.y * o.y) + (o.z * o.z + o.w * o.w); }
        const float rs = rsqrtf(pe::group_sum16(ss) * (1.0f / D) + EPS);
#pragma unroll
        for (int k = 0; k < 4; ++k)
#pragma unroll
            for (int dd = 0; dd < 4; ++dd) { const int col = 256 * k + 64 * dd + 4 * i;
                f32x4 o = (f32x4){acc[8 * k + 2 * dd].x, acc[8 * k + 2 * dd].y, acc[8 * k + 2 * dd + 1].x, acc[8 * k + 2 * dd + 1].y};
                if (fin) o = o * rs * *(const f32x4*)(final_g + col);
                *(f32x4*)(out + (size_t)row * D + col) = o;
                if (!fin) {
                    const float* na = nx_ada + (size_t)(row / SEQ) * 6 * D;
                    const f32x4 y = o * rs * *(const f32x4*)(nx_g + col) * (*(const f32x4*)(na + D + col) + 1.0f) + *(const f32x4*)(na + col);
                    v2u w; w.x = pk2(y.x, y.y); w.y = pk2(y.z, y.w); *(v2u*)(Hn + (size_t)row * D + col) = w; } }
    }
}
#endif
__global__ void __launch_bounds__(256) k_ksum(const bf16_t* proj, float* ksum) {
    const int gid = blockIdx.x * 256 + threadIdx.x;
    const int d = gid & 63, n = (gid >> 6) & 7, h = (gid >> 9) & 7, b = gid >> 12;
    float s = 0.f;
    for (int i = 0; i < MOBA; ++i) s += bf2f(proj[(size_t)(b * SEQ + n * MOBA + i) * INC + OKK + h * HD + d]);
    ksum[gid] = s;
}

__global__ void __launch_bounds__(64) k_attn_naive(const bf16_t* proj, const float* ksum, bf16_t* ya) {
    __shared__ float so[64];
    const int gid = blockIdx.x, h = gid & 7, row = gid >> 3, b = row / SEQ, t = row % SEQ, qb = t / MOBA, lane = threadIdx.x;
    const bf16_t* qp = proj + (size_t)row * INC + OQ + h * HD;
    float q[HD];
#pragma unroll
    for (int d = 0; d < HD; ++d) q[d] = bf2f(qp[d]);
    float g = -3.0e38f;
    if (lane < qb) { g = 0.f; const float* ks = ksum + (size_t)((b * 8 + h) * 8 + lane) * 64;
#pragma unroll
        for (int d = 0; d < HD; ++d) g += q[d] * ks[d]; }
    unsigned sel = 0;
    for (int r = 0; r < 3; ++r) {
        float best = 0.f; int bi = -1;
        for (int n = 0; n < 8; ++n) { const float gn = __shfl(g, n); if (n < qb && !((sel >> n) & 1u) && (bi < 0 || gn > best)) { best = gn; bi = n; } }
        if (bi >= 0) sel |= 1u << bi;
    }
    const float s2 = exp2f(-(float)(h + 1)) * LOG2E;
    float mrun = -1.0e30f, lrun = 0.f, o[HD];
#pragma unroll
    for (int d = 0; d < HD; ++d) o[d] = 0.f;
    for (int n = 0; n <= qb; ++n) {
        if (n < qb && !((sel >> n) & 1u)) continue;
        for (int i = lane; i < MOBA; i += 64) {
            const int j = n * MOBA + i;
            if (j > t) continue;
            const bf16_t* kr = proj + (size_t)(b * SEQ + j) * INC + OKK + h * HD;
            const bf16_t* vr = proj + (size_t)(b * SEQ + j) * INC + OV + h * HD;
            float s = 0.f;
#pragma unroll
            for (int d = 0; d < HD; ++d) s += q[d] * bf2f(kr[d]);
            s -= s2 * (float)(t - j);
            const float mn = fmaxf(mrun, s), f = exp2f(mrun - mn), p = exp2f(s - mn);
            lrun = lrun * f + p;
#pragma unroll
            for (int d = 0; d < HD; ++d) o[d] = o[d] * f + p * bf2f(vr[d]);
            mrun = mn;
        }
    }
    const float mall = wave_max(mrun), f = exp2f(mrun - mall);
    lrun = wave_sum(lrun * f);
#pragma unroll
    for (int d = 0; d < HD; ++d) { const float v = wave_sum(o[d] * f); if (lane == 0) so[d] = v; }
    __syncthreads();
    ya[(size_t)row * 512 + h * HD + lane] = f2bf(so[lane] / lrun);
}

__global__ void __launch_bounds__(64) k_score_topk(const bf16_t* qp, const float* sub_keys_l, float* tv, int* ti) {
    extern __shared__ float sm[];
    float* qs = sm;
    float* sc = sm + 64 * 129;
    const int t = threadIdx.x, row0 = blockIdx.x * 64, gp = blockIdx.y;
    for (int i = t; i < 64 * 128; i += 64) { const int r = i >> 7, d = i & 127; qs[r * 129 + d] = bf2f(qp[(size_t)(row0 + r) * QPW + gp * 128 + d]); }
    __syncthreads();
    const float* sk = sub_keys_l + (size_t)gp * NKEY * HALFK;
    for (int key = 0; key < NKEY; ++key) { float a = 0.f; for (int d = 0; d < HALFK; ++d) a += qs[t * 129 + d] * sk[key * HALFK + d]; sc[key * 64 + t] = a; }
    const size_t ob = ((size_t)(row0 + t) * 16 + gp) * 16;
    for (int r = 0; r < PTOP; ++r) {
        float best = sc[t]; int bi = 0;
        for (int key = 1; key < NKEY; ++key) { const float v = sc[key * 64 + t]; if (v > best) { best = v; bi = key; } }
        tv[ob + r] = best; ti[ob + r] = bi; sc[bi * 64 + t] = -3.0e38f;
    }
}
__global__ void __launch_bounds__(32) k_cand(const float* tv, const int* ti, int* eidx, float* egate) {
    __shared__ float cand[256 * 32];
    const int t = threadIdx.x, gid = blockIdx.x * 32 + t, hh = gid & 7, row = gid >> 3;
    const size_t b0 = ((size_t)row * 16 + hh * 2) * 16, b1 = b0 + 16;
    for (int i = 0; i < 16; ++i) for (int j = 0; j < 16; ++j) cand[(i * 16 + j) * 32 + t] = tv[b0 + i] + tv[b1 + j];
    float bv[PTOP]; int bp[PTOP];
#pragma unroll
    for (int r = 0; r < PTOP; ++r) {
        float best = cand[t]; int bi = 0;
        for (int p = 1; p < 256; ++p) { const float v = cand[p * 32 + t]; if (v > best) { best = v; bi = p; } }
        bv[r] = best; bp[r] = bi; cand[bi * 32 + t] = -3.0e38f;
    }
    float mx = bv[0], sum = 0.f;
#pragma unroll
    for (int r = 0; r < PTOP; ++r) { bv[r] = __expf(bv[r] - mx); sum += bv[r]; }
    const float inv = 1.0f / sum;
#pragma unroll
    for (int r = 0; r < PTOP; ++r) { eidx[(size_t)row * 128 + hh * 16 + r] = ti[b0 + (bp[r] >> 4)] * NKEY + ti[b1 + (bp[r] & 15)]; egate[(size_t)row * 128 + hh * 16 + r] = bv[r] * inv; }
}

template <bool FINAL>
__global__ void __launch_bounds__(256) k_peer_naive(const bf16_t* H, const float* x1, const int* eidx, const float* egate, const float* eu, const float* ev, const float* ada_l, const float* final_g, float* out) {
    const int row = blockIdx.x * 4 + (threadIdx.x >> 6), lane = threadIdx.x & 63, b = row / SEQ;
    float hv[16], acc[16];
#pragma unroll
    for (int i = 0; i < 4; ++i)
#pragma unroll
        for (int j = 0; j < 4; ++j) { hv[4 * i + j] = bf2f(H[(size_t)row * D + i * 256 + lane * 4 + j]); acc[4 * i + j] = 0.f; }
    for (int e = 0; e < 128; ++e) {
        const int idx = eidx[(size_t)row * 128 + e]; const float g = egate[(size_t)row * 128 + e];
        const float* ur = eu + (size_t)idx * D; const float* vr = ev + (size_t)idx * D;
        float dsum = 0.f;
#pragma unroll
        for (int i = 0; i < 4; ++i) { const float4 u = *(const float4*)(ur + i * 256 + lane * 4); dsum += hv[4 * i] * u.x + hv[4 * i + 1] * u.y + hv[4 * i + 2] * u.z + hv[4 * i + 3] * u.w; }
        dsum = wave_sum(dsum);
        const float cc = g * gelu_tanh(dsum);
#pragma unroll
        for (int i = 0; i < 4; ++i) { const float4 v = *(const float4*)(vr + i * 256 + lane * 4); acc[4 * i] += cc * v.x; acc[4 * i + 1] += cc * v.y; acc[4 * i + 2] += cc * v.z; acc[4 * i + 3] += cc * v.w; }
    }
    const float* g2 = ada_l + (size_t)b * 6 * D + 5 * D;
    float o[16]; float ss = 0.f;
#pragma unroll
    for (int i = 0; i < 4; ++i)
#pragma unroll
        for (int j = 0; j < 4; ++j) { const int col = i * 256 + lane * 4 + j; o[4 * i + j] = x1[(size_t)row * D + col] + g2[col] * acc[4 * i + j]; ss += o[4 * i + j] * o[4 * i + j]; }
    if (FINAL) {
        ss = wave_sum(ss);
        const float r = rsqrtf(ss * (1.0f / D) + EPS);
#pragma unroll
        for (int i = 0; i < 4; ++i)
#pragma unroll
            for (int j = 0; j < 4; ++j) { const int col = i * 256 + lane * 4 + j; o[4 * i + j] = o[4 * i + j] * r * final_g[col]; }
    }
#pragma unroll
    for (int i = 0; i < 4; ++i) *(float4*)(out + (size_t)row * D + i * 256 + lane * 4) = make_float4(o[4 * i], o[4 * i + 1], o[4 * i + 2], o[4 * i + 3]);
}


constexpr int N_STEPS = 1 + 9 * DEPTH;
struct Args { const float* in[16]; float* out; unsigned char* ws; int s_lo, s_hi, li, pad; };

__global__ void __launch_bounds__(NWAVES * 64, 2) mega(Args args) {
    extern __shared__ __attribute__((aligned(16))) unsigned char lds_raw[];
    Frame F;
    F.lds = (LAS unsigned char*)lds_raw;
    F.tid = threadIdx.x; F.lane = F.tid & 63; F.wave = __builtin_amdgcn_readfirstlane(F.tid >> 6);
    F.G = gridDim.x; { const int bx = blockIdx.x; F.vcu = (F.G % 8 == 0) ? (bx % 8) * (F.G / 8) + bx / 8 : bx; }
    gu32* ctl = (gu32*)(args.ws + WS_CTL);
    volatile LAS unsigned* MISC = (volatile LAS unsigned*)(F.lds + MISC_OFF);
    for (int u = F.tid; u < (LDS_BYTES - LDSCTL_OFF) / 4; u += NWAVES * 64) ((LAS unsigned*)(F.lds + LDSCTL_OFF))[u] = 0u;
    __syncthreads();
    const bool multi = (args.s_hi - args.s_lo) > 1;
    XcdBarrier bar; bar.bar = (unsigned*)(ctl + CW_BAR) + args.li * XCD_BAR_WORDS; bar.x = 0; bar.st = MISC + 8;
    if (multi) bar = xcd_barrier_post((unsigned*)(ctl + CW_BAR) + args.li * XCD_BAR_WORDS, MISC + 8);

    const int vcu0 = F.vcu;
#ifdef PROBE_MASK
    for (int s2_ = 2 * args.s_lo; s2_ < 2 * args.s_hi; ++s2_) { const int s = s2_ >> 1;
        { const int ptype_ = (s == 0) ? 0 : 1 + (s - 1) % 9; if ((s2_ & 1) && !((PROBE_MASK >> ptype_) & 1)) continue; }
#else
    for (int s = args.s_lo; s < args.s_hi; ++s) {
#endif
        F.tid = laundered_tid(); F.lane = F.tid & 63; F.wave = __builtin_amdgcn_readfirstlane(F.tid >> 6);
        { int v_ = vcu0; asm volatile("" : "+s"(v_)); F.vcu = v_; }
        size_t zoff_ = 0; asm volatile("" : "+s"(zoff_));
        unsigned char* ws = args.ws + zoff_;
        float* ada = (float*)(ws + WS_ADA);
        bf16_t* H = (bf16_t*)(ws + WS_H); bf16_t* proj = (bf16_t*)(ws + WS_PROJ); bf16_t* qp = (bf16_t*)(ws + WS_QP);
        bf16_t* ya = (bf16_t*)(ws + WS_YA); bf16_t* yc = (bf16_t*)(ws + WS_YC); bf16_t* mrg = (bf16_t*)(ws + WS_MRG);
        float* x1 = (float*)(ws + WS_X1); int* eidx = (int*)(ws + WS_EIDX); float* egate = (float*)(ws + WS_EGATE);
        if (s == 0) {
            P0Args a{args.in[1], args.in[4], args.in[5], args.in[6], args.in[8], args.in[9], args.in[10], args.in[11], args.in[12], args.in[13], args.in[14], ws};
            p0_prologue(F, a);
        } else {
            const int l = (s - 1) / 9, ph = (s - 1) % 9;
            if (ph == 0 && l > 0) continue;
            const float* xl = (l == 0) ? args.in[0] : (const float*)args.out;
            const float* ada_l = ada + (size_t)l * BATCH * 6 * D;
            if (ph == 0) {
                norm_phase(F, xl, args.in[2] + l * D, ada_l, 0, D, H);
            } else if (ph == 1) {
                pg8::Gemm g{H, (const bf16_t*)(ws + WS_WIN) + (size_t)l * INC * D, M, INC, D}; pg8::StaticOrder S; S.init(M, INC, F.G, (int)blockIdx.x);
                pg8::EpiBf16S E{proj, INC, 512, C2};
                pg8::gemm_phase<pg8::EpiBf16S, pg8::StaticOrder, true, true>(F.lds + RING_OFF, g, S, E);
            } else if (ph == 2) {
#if !USE_NAIVE_AT
                attn_phase_all(F, proj, ya);
#endif
                conv_phase(F, proj, args.in[7] + l * 3 * 512, yc);
            } else if (ph == 3) {
                { pg8::Gemm g{ya, (const bf16_t*)(ws + WS_WAP) + (size_t)l * D * 512, M, D, 512}; pg8::StaticOrder S; S.init(M, D, F.G, (int)blockIdx.x);
                  pg8::EpiGate<true> E{proj + OGA, mrg};
                  pg8::gemm_phase<pg8::EpiGate<true>, pg8::StaticOrder, true, true>(F.lds + RING_OFF, g, S, E); }
                { pg8::Gemm g{yc, (const bf16_t*)(ws + WS_WCP) + (size_t)l * D * 512, M, D, 512}; pg8::StaticOrder S; S.init(M, D, F.G, (int)blockIdx.x);
                  pg8::EpiGate<false> E{proj + OGC, mrg};
                  pg8::gemm_phase<pg8::EpiGate<false>, pg8::StaticOrder, true, true>(F.lds + RING_OFF, g, S, E); }
            } else if (ph == 4) {
                pg8::Gemm g{mrg, (const bf16_t*)(ws + WS_WOUT) + (size_t)l * D * D, M, D, D}; pg8::StaticOrder S; S.init(M, D, F.G, (int)blockIdx.x);
                pg8::EpiResid E{xl, ada_l, x1};
                pg8::gemm_phase<pg8::EpiResid, pg8::StaticOrder, true, true>(F.lds + RING_OFF, g, S, E);
            } else if (ph == 5) {
                norm_phase(F, x1, args.in[3] + l * D, ada_l, 3 * D, 4 * D, H);
            } else if (ph == 6) {
                pg8::Gemm g{H, (const bf16_t*)(ws + WS_WQ) + (size_t)l * QPW * D, M, QPW, D}; pg8::StaticOrder S; S.init(M, QPW, F.G, (int)blockIdx.x);
                pg8::EpiBf16S E{qp, QPW, 0, 1.0f};
                pg8::gemm_phase<pg8::EpiBf16S, pg8::StaticOrder, true, true>(F.lds + RING_OFF, g, S, E);
            } else if (ph == 7) {
#if !USE_NAIVE_TK
                topk_phase(F, qp, (const bf16_t*)(ws + WS_SK) + (size_t)l * 16 * NKEY * HALFK, eidx, egate);
#endif
            } else {
#if !USE_NAIVE_PE
                peer_phase(F, l, H, x1, eidx, egate, ws + WS_EU + (size_t)l * NEXP * D, ws + WS_EV + (size_t)l * NEXP * D, (const float*)(ws + WS_ESU) + l * NEXP, (const float*)(ws + WS_ESV) + l * NEXP, ada_l, args.in[15], args.out, args.in[2] + (l + 1) * D, ada + (size_t)(l + 1) * BATCH * 6 * D, H);
#endif
            }
        }
#ifdef PROBE_MASK
        if (s2_ + 1 < 2 * args.s_hi) xcd_barrier(bar);
#else
        if (s + 1 < args.s_hi) xcd_barrier(bar);
#endif
    }
}

extern "C" void kernel_launch(void* const* d_in, const int* in_sizes, int n_in, void* d_out, int out_size, void* d_ws, size_t ws_size, hipStream_t stream) {
    static int grid = 0;
    if (grid == 0) {
        if (n_in != 16 || out_size != M * D || ws_size < WS_END) { fprintf(stderr, "kernel_launch: unexpected shapes (n_in %d out %d ws %zu)\n", n_in, out_size, ws_size); grid = -1; return; }
        int dev = 0, cus = 0, per_cu = 0;
        if (hipGetDevice(&dev) != hipSuccess || hipDeviceGetAttribute(&cus, hipDeviceAttributeMultiprocessorCount, dev) != hipSuccess) { grid = -1; return; }
        if (hipFuncSetAttribute((const void*)mega, hipFuncAttributeMaxDynamicSharedMemorySize, LDS_BYTES) != hipSuccess) { fprintf(stderr, "kernel_launch: hipFuncSetAttribute failed\n"); grid = -1; return; }
        if (hipOccupancyMaxActiveBlocksPerMultiprocessor(&per_cu, (const void*)mega, NWAVES * 64, LDS_BYTES) != hipSuccess || per_cu < 1) { fprintf(stderr, "kernel_launch: occupancy query says %d blocks/CU\n", per_cu); per_cu = 1; }
        (void)hipGetLastError();
        grid = cus * 1;
#if USE_NAIVE_TK
        (void)hipFuncSetAttribute((const void*)k_score_topk, hipFuncAttributeMaxDynamicSharedMemorySize, (64 * 129 + 128 * 64) * 4);
#endif
        fprintf(stderr, "kernel_launch: grid %d (cus %d, occupancy %d/CU)\n", grid, cus, per_cu);
    }
    if (grid < 0) return;
    (void)hipMemsetAsync((char*)d_ws + WS_CTL, 0, CTL_ZERO_BYTES, stream);
    Args a{};
    for (int i = 0; i < 16; ++i) a.in[i] = (const float*)d_in[i];
    a.out = (float*)d_out; a.ws = (unsigned char*)d_ws;
#if MEGA_ONE
    a.s_lo = 0; a.s_hi = N_STEPS; a.li = 0;
    void* kargs[] = {&a};
    hipError_t e = hipLaunchCooperativeKernel((const void*)mega, dim3(grid), dim3(NWAVES * 64), kargs, LDS_BYTES, stream);
    if (e != hipSuccess) fprintf(stderr, "kernel_launch: cooperative launch failed: %s (grid %d)\n", hipGetErrorString(e), grid);
#else
    unsigned char* ws = (unsigned char*)d_ws; float* out = (float*)d_out;
    float* ada = (float*)(ws + WS_ADA); float* ksum = (float*)(ws + WS_KSUM);
    bf16_t* H = (bf16_t*)(ws + WS_H); bf16_t* proj = (bf16_t*)(ws + WS_PROJ); bf16_t* qp = (bf16_t*)(ws + WS_QP);
    float* tv = (float*)(ws + WS_TV); int* ti = (int*)(ws + WS_TI);
    bf16_t* ya = (bf16_t*)(ws + WS_YA);
    float* x1 = (float*)(ws + WS_X1); int* eidx = (int*)(ws + WS_EIDX); float* egate = (float*)(ws + WS_EGATE);
    (void)ada; (void)ksum; (void)H; (void)proj; (void)qp; (void)tv; (void)ti; (void)ya; (void)x1; (void)eidx; (void)egate; (void)out;
    for (int s = 0; s < N_STEPS; ++s) {
        const int l = s ? (s - 1) / 9 : 0, ph = s ? (s - 1) % 9 : -1;
        const float* ada_l = ada + (size_t)l * BATCH * 6 * D; (void)ada_l;
#if USE_NAIVE_AT
        if (ph == 2) { k_ksum<<<BATCH * 8 * 8 * 64 / 256, 256, 0, stream>>>(proj, ksum); k_attn_naive<<<M * NH, 64, 0, stream>>>(proj, ksum, ya); }
#endif
#if USE_NAIVE_TK
        if (ph == 7) { k_score_topk<<<dim3(M / 64, 16), 64, (64 * 129 + 128 * 64) * 4, stream>>>(qp, (const float*)d_in[12] + (size_t)l * PH * 2 * NKEY * HALFK, tv, ti); k_cand<<<M * PH / 32, 32, 0, stream>>>(tv, ti, eidx, egate); continue; }
#endif
#if USE_NAIVE_PE
        if (ph == 8) {
            const float* eu = (const float*)d_in[13] + (size_t)l * NEXP * D; const float* ev = (const float*)d_in[14] + (size_t)l * NEXP * D;
            if (l == DEPTH - 1) k_peer_naive<true><<<M / 4, 256, 0, stream>>>(H, x1, eidx, egate, eu, ev, ada_l, (const float*)d_in[15], out);
            else k_peer_naive<false><<<M / 4, 256, 0, stream>>>(H, x1, eidx, egate, eu, ev, ada_l, (const float*)d_in[15], out);
            continue; }
#endif
        a.s_lo = s; a.s_hi = s + 1; a.li = 0;
        hipLaunchKernelGGL(mega, dim3(grid), dim3(NWAVES * 64), LDS_BYTES, stream, a);
    }
#endif
}
```
